# Optimizing an MI355X kernel written in HIP

```python
import jax, jax.numpy as jnp
from jax import lax
import numpy as np

D_MODEL = 1024
BATCH = 16
SEQ = 2048
DEPTH = 1

M_HEADS = 4
M_V_DIM = 128
M_QK_DIM = 64
M_CHUNK = 64
A_HEADS = 8
A_HEAD_DIM = 64
WINDOWS = (128, 512, 2048)
DILATIONS = (1, 4, 16)
ROT_DIM = A_HEAD_DIM // 4
ROPE_THETA = 500000.0
MIX_WIDTH = M_HEADS * M_V_DIM + A_HEADS * A_HEAD_DIM
IN_SPLITS = (M_HEADS * M_QK_DIM, M_HEADS * M_QK_DIM, M_HEADS * M_V_DIM, M_HEADS * M_V_DIM,
             4 * M_HEADS, A_HEADS * A_HEAD_DIM, A_HEADS * A_HEAD_DIM, A_HEADS * A_HEAD_DIM)
IN_COLS = sum(IN_SPLITS)
D_FF = 2816
N_MOD = 9
HALF_STEP = 0.5
EPS = 1e-6
NEG_INF = -1e30

kernel_name = 'hybrid_mlstm_dilated_attn_macaron_adaln'


def rms_norm(x, g):
    xf = x.astype(jnp.float32)
    y = xf * lax.rsqrt(jnp.mean(xf * xf, axis=-1, keepdims=True) + EPS)
    return (y * g.astype(jnp.float32)).astype(x.dtype)


def modulate(h, shift, scale):
    return h * (1.0 + scale) + shift


def swiglu(h, w_gu, w_down):
    g, u = jnp.split(h @ w_gu, 2, axis=-1)
    return (jax.nn.silu(g) * u) @ w_down


def partial_rope(t, pos):
    half = ROT_DIM // 2
    inv_freq = ROPE_THETA ** (-2.0 * jnp.arange(half, dtype=jnp.float32) / ROT_DIM)
    ang = pos.astype(jnp.float32)[:, None] * inv_freq[None, :]
    cos, sin = jnp.cos(ang), jnp.sin(ang)
    t1, t2 = t[..., :half], t[..., half:ROT_DIM]
    return jnp.concatenate([t1 * cos - t2 * sin, t2 * cos + t1 * sin, t[..., ROT_DIM:]], axis=-1)


def mlstm_scan(q, k, v, log_i, log_f):
    B, H, S, Dk = q.shape
    Dv = v.shape[-1]
    lc = min(M_CHUNK, S)
    nc = S // lc

    def chunks(t):
        return jnp.moveaxis(t.reshape((B, H, nc, lc) + t.shape[3:]), 2, 0)

    xs = (chunks(q), chunks(k), chunks(v), chunks(log_i), chunks(log_f))
    tril = jnp.tril(jnp.ones((lc, lc), dtype=bool))

    def step(carry, inp):
        C, n, m = carry
        q_c, k_c, v_c, li, lf = inp
        b = jnp.cumsum(lf, axis=-1)
        a_inter = b + m[..., None]
        d = jnp.where(tril, b[..., :, None] - b[..., None, :] + li[..., None, :], NEG_INF)
        m_t = jnp.maximum(a_inter, jnp.max(d, axis=-1))
        w_inter = jnp.exp(a_inter - m_t)
        s = jnp.exp(d - m_t[..., None]) * jnp.einsum('bhtd,bhsd->bhts', q_c, k_c)
        num = (w_inter[..., None] * jnp.einsum('bhvd,bhtd->bhtv', C, q_c)
               + jnp.einsum('bhts,bhsv->bhtv', s, v_c))
        den = w_inter * jnp.einsum('bhd,bhtd->bht', n, q_c) + jnp.sum(s, axis=-1)
        h = num / jnp.maximum(jnp.abs(den), jnp.exp(-m_t))[..., None]
        b_end = b[..., -1]
        g = b_end[..., None] - b + li
        m_new = jnp.maximum(b_end + m, jnp.max(g, axis=-1))
        decay = jnp.exp(b_end + m - m_new)
        wg = jnp.exp(g - m_new[..., None])
        C_new = decay[..., None, None] * C + jnp.einsum('bhs,bhsv,bhsd->bhvd', wg, v_c, k_c)
        n_new = decay[..., None] * n + jnp.einsum('bhs,bhsd->bhd', wg, k_c)
        return (C_new, n_new, m_new), h

    init = (jnp.zeros((B, H, Dv, Dk), jnp.float32), jnp.zeros((B, H, Dk), jnp.float32),
            jnp.full((B, H), NEG_INF, jnp.float32))
    _, hs = lax.scan(step, init, xs)
    return jnp.moveaxis(hs, 0, 2).reshape(B, H, S, Dv)


def bidirectional_mlstm(q, k, v, li_f, lf_f, li_b, lf_b):
    h_fwd = mlstm_scan(q, k, v, li_f, lf_f)
    flip = lambda t: jnp.flip(t, axis=2)
    h_bwd = flip(mlstm_scan(flip(q), flip(k), flip(v), flip(li_b), flip(lf_b)))
    return h_fwd + h_bwd


def dilated_band_attention(q, k, v, dilation, n_side):
    B, H, S, Dh = q.shape
    L = S // dilation

    def to_sub(t):
        return t.reshape(B, H, L, dilation, Dh).transpose(0, 1, 3, 2, 4)

    blk = n_side
    nb = -(-L // blk)
    lp = nb * blk
    qs = jnp.pad(to_sub(q), ((0, 0),) * 3 + ((0, lp - L), (0, 0)))
    kpad = ((0, 0),) * 3 + ((n_side, lp - L + n_side), (0, 0))
    ks = jnp.pad(to_sub(k), kpad)
    vs = jnp.pad(to_sub(v), kpad)
    qb = qs.reshape(B, H, dilation, nb, blk, Dh)

    def windows(t):
        tb = t.reshape(B, H, dilation, nb + 2, blk, Dh)
        return jnp.concatenate([tb[:, :, :, :-2], tb[:, :, :, 1:-1], tb[:, :, :, 2:]], axis=4)

    kw, vw = windows(ks), windows(vs)
    s = jnp.einsum('bhrnqe,bhrnke->bhrnqk', qb, kw)
    qi = jnp.arange(blk)[:, None]
    kk = jnp.arange(3 * blk)[None, :]
    band = jnp.abs(kk - n_side - qi) <= n_side
    key_idx = jnp.arange(nb)[:, None] * blk + kk - n_side
    in_range = (key_idx >= 0) & (key_idx < L)
    mask = band[None, :, :] & in_range[:, None, :]
    s = jnp.where(mask, s, NEG_INF)
    m = jnp.max(s, axis=-1, keepdims=True)
    p = jnp.exp(s - m)
    den = jnp.sum(p, axis=-1)
    o = jnp.einsum('bhrnqk,bhrnke->bhrnqe', p, vw) / den[..., None]
    lse = m[..., 0] + jnp.log(den)
    o = o.reshape(B, H, dilation, lp, Dh)[:, :, :, :L].transpose(0, 1, 3, 2, 4).reshape(B, H, S, Dh)
    lse = lse.reshape(B, H, dilation, lp)[..., :L].transpose(0, 1, 3, 2).reshape(B, H, S)
    return o, lse


def dilated_attention(q, k, v):
    outs, lses = [], []
    for w, d in zip(WINDOWS, DILATIONS):
        o, l = dilated_band_attention(q, k, v, d, w // (2 * d))
        outs.append(o)
        lses.append(l)
    wts = jax.nn.softmax(jnp.stack(lses), axis=0)
    return jnp.sum(wts[..., None] * jnp.stack(outs), axis=0)


def hybrid_mixer(h, w_in, gate_bias, g_q, g_k, g_mh, w_out):
    B, S, _ = h.shape
    proj = (h @ w_in).astype(jnp.float32)
    idx, acc = [], 0
    for n_cols in IN_SPLITS[:-1]:
        acc += n_cols
        idx.append(acc)
    mq, mk, mv, mo, mg, aq, ak, av = jnp.split(proj, idx, axis=-1)

    def heads(t, n):
        return t.reshape(B, S, n, -1).transpose(0, 2, 1, 3)

    gates = mg.reshape(B, S, 4, M_HEADS).transpose(2, 0, 3, 1) + gate_bias.astype(jnp.float32)[:, None, :, None]
    hm = bidirectional_mlstm(heads(mq, M_HEADS), heads(mk, M_HEADS) * (M_QK_DIM ** -0.5), heads(mv, M_HEADS),
                             gates[0], jax.nn.log_sigmoid(gates[1]), gates[2], jax.nn.log_sigmoid(gates[3]))
    hm = rms_norm(hm.transpose(0, 2, 1, 3), g_mh.reshape(M_HEADS, M_V_DIM))
    hm = (hm * jax.nn.sigmoid(mo.reshape(B, S, M_HEADS, M_V_DIM))).reshape(B, S, M_HEADS * M_V_DIM)

    pos = jnp.arange(S)
    qa = partial_rope(rms_norm(heads(aq, A_HEADS), g_q), pos) * (A_HEAD_DIM ** -0.5)
    ka = partial_rope(rms_norm(heads(ak, A_HEADS), g_k), pos)
    ha = dilated_attention(qa, ka, heads(av, A_HEADS))
    ha = ha.transpose(0, 2, 1, 3).reshape(B, S, A_HEADS * A_HEAD_DIM)

    return jnp.concatenate([hm, ha], axis=-1).astype(h.dtype) @ w_out


def setup_inputs(seed: int = 0) -> dict:
    key = jax.random.key(seed)
    ks = jax.random.split(key, 20)
    f32 = jnp.float32

    def nrm(k, shape, scale):
        return jax.random.normal(k, shape, f32) * scale

    gate_bias = (nrm(ks[9], (DEPTH, 4, M_HEADS), 0.1)
                 + jnp.array([0.0, 1.0, 0.0, 1.0], f32)[None, :, None]
                 * jnp.linspace(3.0, 6.0, M_HEADS, dtype=f32)[None, None, :])
    return {
        'x': nrm(ks[0], (BATCH, SEQ, D_MODEL), 1.0),
        'c': nrm(ks[1], (BATCH, D_MODEL), 1.0),
        'w_ada': nrm(ks[2], (DEPTH, D_MODEL, N_MOD * D_MODEL), 0.5 * D_MODEL ** -0.5),
        'b_ada': nrm(ks[3], (DEPTH, N_MOD * D_MODEL), 0.02),
        'g_ffn1': 1.0 + nrm(ks[4], (DEPTH, D_MODEL), 0.02),
        'w_gu1': nrm(ks[5], (DEPTH, D_MODEL, 2 * D_FF), D_MODEL ** -0.5),
        'w_down1': nrm(ks[6], (DEPTH, D_FF, D_MODEL), D_FF ** -0.5),
        'g_mix': 1.0 + nrm(ks[7], (DEPTH, D_MODEL), 0.02),
        'w_in': nrm(ks[8], (DEPTH, D_MODEL, IN_COLS), D_MODEL ** -0.5),
        'gate_bias': gate_bias,
        'g_q': 1.0 + nrm(ks[10], (DEPTH, A_HEAD_DIM), 0.02),
        'g_k': 1.0 + nrm(ks[11], (DEPTH, A_HEAD_DIM), 0.02),
        'g_mh': 1.0 + nrm(ks[12], (DEPTH, M_HEADS * M_V_DIM), 0.02),
        'w_out': nrm(ks[13], (DEPTH, MIX_WIDTH, D_MODEL), MIX_WIDTH ** -0.5),
        'g_ffn2': 1.0 + nrm(ks[14], (DEPTH, D_MODEL), 0.02),
        'w_gu2': nrm(ks[15], (DEPTH, D_MODEL, 2 * D_FF), D_MODEL ** -0.5),
        'w_down2': nrm(ks[16], (DEPTH, D_FF, D_MODEL), D_FF ** -0.5),
        'g_final': 1.0 + nrm(ks[17], (DEPTH, D_MODEL), 0.02),
    }


def reference(x, c, w_ada, b_ada, g_ffn1, w_gu1, w_down1, g_mix, w_in, gate_bias, g_q, g_k, g_mh,
              w_out, g_ffn2, w_gu2, w_down2, g_final):
    B, S, D = x.shape
    cs = jax.nn.silu(c)
    for l in range(DEPTH):
        mod = (cs @ w_ada[l] + b_ada[l]).reshape(B, N_MOD, D)[:, :, None, :]
        sh1, sc1, gt1, sh2, sc2, gt2, sh3, sc3, gt3 = [mod[:, i] for i in range(N_MOD)]
        h = modulate(rms_norm(x, g_ffn1[l]), sh1, sc1)
        x = x + HALF_STEP * gt1 * swiglu(h, w_gu1[l], w_down1[l])
        h = modulate(rms_norm(x, g_mix[l]), sh2, sc2)
        x = x + gt2 * hybrid_mixer(h, w_in[l], gate_bias[l], g_q[l], g_k[l], g_mh[l], w_out[l])
        h = modulate(rms_norm(x, g_ffn2[l]), sh3, sc3)
        x = x + HALF_STEP * gt3 * swiglu(h, w_gu2[l], w_down2[l])
        x = rms_norm(x, g_final[l])
    return x
```

```cpp
#include <hip/hip_runtime.h>
#include <cstdint>
#include <cstdio>

namespace v1 {
constexpr int D = 1024, NB = 16, S = 2048, T = NB * S, DFF = 2816, NMOD = 9;
constexpr int MH = 4, MV = 128, MQK = 64, AH = 8, AD = 64, INC = 3088;
constexpr float EPS = 1e-6f;
typedef unsigned short bf16;

__device__ __forceinline__ unsigned short f2bf(float f) { unsigned u = __float_as_uint(f); return (unsigned short)((u + 0x7fffu + ((u >> 16) & 1u)) >> 16); }
__device__ __forceinline__ float bf2f(unsigned short h) { return __uint_as_float(((unsigned)h) << 16); }
__device__ __forceinline__ float siluf(float x) { return x / (1.f + expf(-x)); }
__device__ __forceinline__ float sigmoidf_(float x) { return 1.f / (1.f + expf(-x)); }
__device__ __forceinline__ float logsigmoidf_(float x) { return fminf(x, 0.f) - log1pf(expf(-fabsf(x))); }

__global__ void k_mod(const float* c, const float* w, const float* bias, float* mod) {
    int idx = blockIdx.x * blockDim.x + threadIdx.x; if (idx >= NB * NMOD * D) return;
    int b = idx / (NMOD * D), n = idx % (NMOD * D);
    float acc = 0.f;
    for (int k = 0; k < D; ++k) acc += siluf(c[b * D + k]) * w[(size_t)k * (NMOD * D) + n];
    mod[idx] = acc + bias[n];
}

__device__ __forceinline__ float block_sum(float v, float* red) {
    for (int o = 32; o > 0; o >>= 1) v += __shfl_xor(v, o);
    int w = threadIdx.x >> 6; __syncthreads();
    if ((threadIdx.x & 63) == 0) red[w] = v; __syncthreads();
    float s = 0.f; for (int i = 0; i < (int)(blockDim.x >> 6); ++i) s += red[i];
    return s;
}
__global__ void k_normmod(const float* x, const float* g, const float* mod, int shi, int sci, bf16* out) {
    __shared__ float red[8];
    int t = blockIdx.x, b = t / S; const float* xr = x + (size_t)t * D;
    float v[4]; float ss = 0.f;
    for (int i = 0; i < 4; ++i) { v[i] = xr[threadIdx.x + 256 * i]; ss += v[i] * v[i]; }
    ss = block_sum(ss, red);
    float rstd = rsqrtf(ss / D + EPS);
    for (int i = 0; i < 4; ++i) { int k = threadIdx.x + 256 * i;
        float sc = mod[(size_t)b * NMOD * D + sci * D + k], sh = mod[(size_t)b * NMOD * D + shi * D + k];
        out[(size_t)t * D + k] = f2bf(v[i] * rstd * g[k] * (1.f + sc) + sh); }
}
__global__ void k_final(float* x, const float* g) {
    __shared__ float red[8];
    int t = blockIdx.x; float* xr = x + (size_t)t * D;
    float v[4]; float ss = 0.f;
    for (int i = 0; i < 4; ++i) { v[i] = xr[threadIdx.x + 256 * i]; ss += v[i] * v[i]; }
    ss = block_sum(ss, red);
    float rstd = rsqrtf(ss / D + EPS);
    for (int i = 0; i < 4; ++i) { int k = threadIdx.x + 256 * i; xr[k] = v[i] * rstd * g[k]; }
}

template <int EPI>
__global__ void k_gemm(const bf16* A, int lda, const float* W, int ldw, int M, int N, int K,
                       bf16* outb, float* xio, const float* mod, int gi, float coef, float* gates) {
    __shared__ float As[16][65]; __shared__ float Ws[16][64]; __shared__ float Ws2[16][64];
    int tx = threadIdx.x % 16, ty = threadIdx.x / 16;
    int m0 = blockIdx.y * 64, n0 = blockIdx.x * 64;
    float acc[4][4] = {}, acc2[4][4] = {};
    for (int k0 = 0; k0 < K; k0 += 16) {
        for (int i = 0; i < 4; ++i) { int e = threadIdx.x + 256 * i; int r = e / 16, kk = e % 16; As[kk][r] = bf2f(A[(size_t)(m0 + r) * lda + k0 + kk]); }
        for (int i = 0; i < 4; ++i) { int e = threadIdx.x + 256 * i; int kk = e / 64, c = e % 64; int n = n0 + c;
            Ws[kk][c] = (n < N) ? W[(size_t)(k0 + kk) * ldw + n] : 0.f;
            if (EPI == 0) Ws2[kk][c] = W[(size_t)(k0 + kk) * ldw + n + DFF]; }
        __syncthreads();
        for (int kk = 0; kk < 16; ++kk) {
            float a[4], w[4], w2[4];
            for (int i = 0; i < 4; ++i) a[i] = As[kk][ty * 4 + i];
            for (int j = 0; j < 4; ++j) { w[j] = Ws[kk][tx * 4 + j]; if (EPI == 0) w2[j] = Ws2[kk][tx * 4 + j]; }
            for (int i = 0; i < 4; ++i) for (int j = 0; j < 4; ++j) { acc[i][j] += a[i] * w[j]; if (EPI == 0) acc2[i][j] += a[i] * w2[j]; }
        }
        __syncthreads();
    }
    for (int i = 0; i < 4; ++i) for (int j = 0; j < 4; ++j) {
        int t = m0 + ty * 4 + i, n = n0 + tx * 4 + j; if (n >= N) continue;
        if (EPI == 0) outb[(size_t)t * DFF + n] = f2bf(siluf(acc[i][j]) * acc2[i][j]);
        else if (EPI == 1) { int b = t / S; xio[(size_t)t * D + n] += coef * mod[(size_t)b * NMOD * D + gi * D + n] * acc[i][j]; }
        else { outb[(size_t)t * INC + n] = f2bf(acc[i][j]); if (n >= 1536 && n < 1552) gates[(size_t)t * 16 + (n - 1536)] = acc[i][j]; }
    }
}

__global__ void k_qknorm(bf16* proj, const float* gq, const float* gk) {
    int w = (blockIdx.x * blockDim.x + threadIdx.x) / 64, lane = threadIdx.x & 63; if (w >= T * AH * 2) return;
    int which = w % 2, hd = (w / 2) % AH, t = w / (2 * AH); int pos = t % S;
    bf16* p = proj + (size_t)t * INC + (which ? 2064 : 1552) + hd * AD; const float* g = which ? gk : gq;
    float v = bf2f(p[lane]); float ss = v * v; for (int o = 32; o > 0; o >>= 1) ss += __shfl_xor(ss, o);
    v = v * rsqrtf(ss / 64.f + EPS) * g[lane];
    float other = __shfl_xor(v, 8);
    if (lane < 16) { int i = lane & 7; float inv = powf(500000.f, -2.f * (float)i / 16.f); float ang = (float)pos * inv; float cs = cosf(ang), sn = sinf(ang);
        v = (lane < 8) ? (v * cs - other * sn) : (v * cs + other * sn); }
    p[lane] = f2bf(v * (which ? 1.f : 0.125f));
}

__global__ void k_gates(const float* gates, const float* gbias, float* LI, float* BC, float* MT) {
    int chain = blockIdx.x * blockDim.x + threadIdx.x; if (chain >= NB * MH * 2) return;
    int dir = chain % 2, h = (chain / 2) % MH, b = chain / (2 * MH);
    float bc = 0.f, pm = -1e30f;
    for (int j = 0; j < S; ++j) { int t = dir ? (S - 1 - j) : j; const float* g = gates + (size_t)(b * S + t) * 16;
        float li = g[(dir ? 8 : 0) + h] + gbias[(dir ? 2 : 0) * MH + h];
        float lf = logsigmoidf_(g[(dir ? 12 : 4) + h] + gbias[(dir ? 3 : 1) * MH + h]);
        bc += lf; pm = fmaxf(pm, li - bc);
        LI[(size_t)chain * S + j] = li; BC[(size_t)chain * S + j] = bc; MT[(size_t)chain * S + j] = bc + pm; }
}
__global__ void k_mlstm(const bf16* proj, const float* LI, const float* BC, const float* MT, float* H  ) {
    __shared__ float qs[16][65], ks[64][65], vs[64][129], P[16][65];
    int chain = blockIdx.y, dir = chain % 2, h = (chain / 2) % MH, b = chain / (2 * MH);
    int j0 = blockIdx.x * 16; int tid = threadIdx.x;
    const float* li = LI + (size_t)chain * S; const float* bc = BC + (size_t)chain * S; const float* mt = MT + (size_t)chain * S;
    for (int e = tid; e < 16 * 64; e += 256) { int r = e / 64, d = e % 64; int j = j0 + r; int t = dir ? S - 1 - j : j; qs[r][d] = bf2f(proj[(size_t)(b * S + t) * INC + h * 64 + d]); }
    int tq = tid / 16, vg = tid % 16;
    float num[8] = {}; float den = 0.f;
    for (int s0 = 0; s0 <= j0 + 15; s0 += 64) {
        __syncthreads();
        for (int e = tid; e < 64 * 64; e += 256) { int r = e / 64, d = e % 64; int j = s0 + r; float v = 0.f; if (j < S) { int t = dir ? S - 1 - j : j; v = bf2f(proj[(size_t)(b * S + t) * INC + 256 + h * 64 + d]) * 0.125f; } ks[r][d] = v; }
        for (int e = tid; e < 64 * 128; e += 256) { int r = e / 128, d = e % 128; int j = s0 + r; float v = 0.f; if (j < S) { int t = dir ? S - 1 - j : j; v = bf2f(proj[(size_t)(b * S + t) * INC + 512 + h * 128 + d]); } vs[r][d] = v; }
        __syncthreads();
        for (int i = 0; i < 4; ++i) { int sl = vg * 4 + i; int js = s0 + sl; int jq = j0 + tq; float p = 0.f;
            if (js <= jq && js < S) { float dot = 0.f; for (int d = 0; d < 64; ++d) dot += qs[tq][d] * ks[sl][d];
                p = expf(bc[jq] - bc[js] + li[js] - mt[jq]) * dot; }
            P[tq][sl] = p; }
        __syncthreads();
        for (int sl = 0; sl < 64; ++sl) { float p = P[tq][sl]; den += p; for (int i = 0; i < 8; ++i) num[i] += p * vs[sl][vg * 8 + i]; }
    }
    int jq = j0 + tq; int t = dir ? S - 1 - jq : jq;
    float dn = fmaxf(fabsf(den), expf(-mt[jq]));
    for (int i = 0; i < 8; ++i) H[((size_t)dir * T + (size_t)(b * S + t)) * 512 + h * 128 + vg * 8 + i] = num[i] / dn;
}
__global__ void k_mlstm_fin(const float* H, const bf16* proj, const float* gmh, bf16* hmix) {
    int w = (blockIdx.x * blockDim.x + threadIdx.x) / 64, lane = threadIdx.x & 63; if (w >= T * MH) return;
    int h = w % MH, t = w / MH;
    float a0 = H[(size_t)t * 512 + h * 128 + lane] + H[((size_t)T + t) * 512 + h * 128 + lane];
    float a1 = H[(size_t)t * 512 + h * 128 + 64 + lane] + H[((size_t)T + t) * 512 + h * 128 + 64 + lane];
    float ss = a0 * a0 + a1 * a1; for (int o = 32; o > 0; o >>= 1) ss += __shfl_xor(ss, o);
    float r = rsqrtf(ss / 128.f + EPS);
    float o0 = bf2f(proj[(size_t)t * INC + 1024 + h * 128 + lane]), o1 = bf2f(proj[(size_t)t * INC + 1024 + h * 128 + 64 + lane]);
    hmix[(size_t)t * D + h * 128 + lane] = f2bf(a0 * r * gmh[h * 128 + lane] * sigmoidf_(o0));
    hmix[(size_t)t * D + h * 128 + 64 + lane] = f2bf(a1 * r * gmh[h * 128 + 64 + lane] * sigmoidf_(o1));
}
__global__ void k_attn(const bf16* proj, bf16* hmix) {
    int w = (blockIdx.x * blockDim.x + threadIdx.x) / 64, lane = threadIdx.x & 63; if (w >= T * AH) return;
    int hd = w % AH, tg = w / AH, b = tg / S, t = tg % S;
    float q = bf2f(proj[(size_t)tg * INC + 1552 + hd * AD + lane]);
    float m = -1e30f, l = 0.f, o = 0.f;
    for (int p = 0; p < 3; ++p) { int dil = p == 0 ? 1 : (p == 1 ? 4 : 16);
        for (int j = -64; j <= 64; ++j) { int tk = t + j * dil; if (tk < 0 || tk >= S) continue;
            size_t row = (size_t)(b * S + tk) * INC;
            float s = q * bf2f(proj[row + 2064 + hd * AD + lane]);
            for (int of = 32; of > 0; of >>= 1) s += __shfl_xor(s, of);
            float mn = fmaxf(m, s), f = expf(m - mn), pe = expf(s - mn);
            l = l * f + pe; o = o * f + pe * bf2f(proj[row + 2576 + hd * AD + lane]); m = mn; } }
    hmix[(size_t)tg * D + 512 + hd * AD + lane] = f2bf(o / l);
}
}

extern "C" void kernel_launch(void* const* d_in, const int* in_sizes, int n_in, void* d_out, int out_size, void* d_ws, size_t ws_size, hipStream_t stream) {
    using namespace v1;
    const float* x = (const float*)d_in[0]; const float* c = (const float*)d_in[1]; const float* w_ada = (const float*)d_in[2]; const float* b_ada = (const float*)d_in[3];
    const float* g_ffn1 = (const float*)d_in[4]; const float* w_gu1 = (const float*)d_in[5]; const float* w_down1 = (const float*)d_in[6]; const float* g_mix = (const float*)d_in[7];
    const float* w_in = (const float*)d_in[8]; const float* gate_bias = (const float*)d_in[9]; const float* g_q = (const float*)d_in[10]; const float* g_k = (const float*)d_in[11];
    const float* g_mh = (const float*)d_in[12]; const float* w_out = (const float*)d_in[13]; const float* g_ffn2 = (const float*)d_in[14]; const float* w_gu2 = (const float*)d_in[15];
    const float* w_down2 = (const float*)d_in[16]; const float* g_final = (const float*)d_in[17];
    float* out = (float*)d_out; unsigned char* ws = (unsigned char*)d_ws;
    const size_t MiB = 1u << 20;
    float* mod = (float*)(ws + 0);
    float* gates = (float*)(ws + 1 * MiB);
    float* LI = (float*)(ws + 4 * MiB); float* BC = (float*)(ws + 6 * MiB); float* MT = (float*)(ws + 8 * MiB);
    bf16* hbuf = (bf16*)(ws + 16 * MiB);
    bf16* act = (bf16*)(ws + 80 * MiB);
    bf16* proj = act;
    float* H = (float*)(ws + 288 * MiB);
    hipMemcpyAsync(out, x, (size_t)T * D * 4, hipMemcpyDeviceToDevice, stream);
    k_mod<<<(NB * NMOD * D + 255) / 256, 256, 0, stream>>>(c, w_ada, b_ada, mod);
    k_normmod<<<T, 256, 0, stream>>>(out, g_ffn1, mod, 0, 1, hbuf);
    k_gemm<0><<<dim3(DFF / 64, T / 64), 256, 0, stream>>>(hbuf, D, w_gu1, 2 * DFF, T, DFF, D, act, nullptr, nullptr, 0, 0.f, nullptr);
    k_gemm<1><<<dim3(D / 64, T / 64), 256, 0, stream>>>(act, DFF, w_down1, D, T, D, DFF, nullptr, out, mod, 2, 0.5f, nullptr);
    k_normmod<<<T, 256, 0, stream>>>(out, g_mix, mod, 3, 4, hbuf);
    k_gemm<2><<<dim3((INC + 63) / 64, T / 64), 256, 0, stream>>>(hbuf, D, w_in, INC, T, INC, D, proj, nullptr, nullptr, 0, 0.f, gates);
    k_qknorm<<<(T * AH * 2 * 64 + 255) / 256, 256, 0, stream>>>(proj, g_q, g_k);
    k_gates<<<(NB * MH * 2 + 63) / 64, 64, 0, stream>>>(gates, gate_bias, LI, BC, MT);
    k_mlstm<<<dim3(S / 16, NB * MH * 2), 256, 0, stream>>>(proj, LI, BC, MT, H);
    k_mlstm_fin<<<(T * MH * 64 + 255) / 256, 256, 0, stream>>>(H, proj, g_mh, hbuf);
    k_attn<<<(T * AH * 64 + 255) / 256, 256, 0, stream>>>(proj, hbuf);
    k_gemm<1><<<dim3(D / 64, T / 64), 256, 0, stream>>>(hbuf, D, w_out, D, T, D, D, nullptr, out, mod, 5, 1.0f, nullptr);
    k_normmod<<<T, 256, 0, stream>>>(out, g_ffn2, mod, 6, 7, hbuf);
    k_gemm<0><<<dim3(DFF / 64, T / 64), 256, 0, stream>>>(hbuf, D, w_gu2, 2 * DFF, T, DFF, D, act, nullptr, nullptr, 0, 0.f, nullptr);
    k_gemm<1><<<dim3(D / 64, T / 64), 256, 0, stream>>>(act, DFF, w_down2, D, T, D, DFF, nullptr, out, mod, 8, 0.5f, nullptr);
    k_final<<<T, 256, 0, stream>>>(out, g_final);
}
```

```cpp
#include <hip/hip_runtime.h>
#include <cstdio>
#include <cstdint>

constexpr int D = 1024, NB = 16, S = 2048, T = NB * S, DFF = 2816, NMOD = 9;
constexpr int MH = 4, MV = 128, MQK = 64, AH = 8, AD = 64, INC = 3088, PW = 3072;
constexpr float EPS = 1e-6f;
namespace pg8 {
#define PG8_LAS __attribute__((address_space(3)))
typedef unsigned short bf16_t;
typedef short bf16x8 __attribute__((ext_vector_type(8)));
typedef float f32x4 __attribute__((ext_vector_type(4)));
typedef unsigned u32x4 __attribute__((ext_vector_type(4)));
constexpr int BM = 256, BK = 64, HALF = 128, HTB = HALF * BK * 2  , STAGE_BYTES = 8 * HTB, NXCD = 8, WGM = 8;

__host__ __device__ __forceinline__ int lds_byte(int r, int c) { const int st = (r >> 4) * 2 + (c >> 5), rr = r & 15, cc = c & 31, ob = rr * 64 + cc * 2; return st * 1024 + (ob ^ (((ob >> 9) & 1) << 5)); }
__host__ __device__ __forceinline__ void stage_rc(int b, int& R, int& C) { const int st = b / 1024, sb = b % 1024, swz = sb ^ (((sb >> 9) & 1) << 5); R = (st >> 1) * 16 + swz / 64; C = (st & 1) * 32 + (swz % 64) / 2; }
__host__ __device__ __forceinline__ int perm32(int rho) { const int n = rho >> 4, i = rho & 15; return 8 * (i >> 2) + 4 * n + (i & 3); }

struct Unit { int pm, pn; };
struct Gemm { const bf16_t* A; const bf16_t* Bt; int M, N, K; };

struct StaticOrder {
    int nM, nN, nwg, G, c;
    __host__ __device__ void init(int M, int N, int G_, int c_) { nM = M / BM; nN = N / BM; nwg = nM * nN; G = G_; c = c_; }
    __host__ __device__ bool next(int i, Unit& u) const {
        const long L = (long)i * G + c; if (L >= nwg) return false;
        int wgid = (int)L; { const int q = nwg / NXCD, r = nwg % NXCD, xcd = wgid % NXCD, off = wgid / NXCD; wgid = (xcd < r ? xcd * (q + 1) : r * (q + 1) + (xcd - r) * q) + off; }
        const int nig = WGM * nN, gid = wgid / nig, fm = gid * WGM, gsz = (nM - fm) < WGM ? (nM - fm) : WGM;
        u.pm = fm + ((wgid % nig) % gsz); u.pn = (wgid % nig) / gsz; return true;
    }
    __device__ __forceinline__ void a_ready(const Unit&) const {}
    __device__ __forceinline__ void done(const Unit&) const {}
};

__device__ __forceinline__ unsigned cvt_pk_bf16(float lo, float hi) { unsigned r; asm volatile("v_cvt_pk_bf16_f32 %0, %1, %2" : "=v"(r) : "v"(lo), "v"(hi)); return r; }
typedef float f32x2 __attribute__((ext_vector_type(2)));
constexpr int T_ = 32768;
__device__ __forceinline__ float fast_silu(float x) { return x * __builtin_amdgcn_rcpf(1.f + __expf(-x)); }
__device__ __forceinline__ float row_rstd(const float* ssq, int row, int fq) {
    float s = 0.f;
#pragma unroll
    for (int i = 0; i < 4; ++i) s += ssq[(size_t)(4 * fq + i) * T_ + row];
    s += __shfl_xor(s, 16); s += __shfl_xor(s, 32);
    return rsqrtf(s * (1.0f / 1024.0f) + 1e-6f);
}
__device__ __forceinline__ u32x4 pack8(const f32x4& a, const f32x4& b) { u32x4 w; w.x = cvt_pk_bf16(a[0], a[1]); w.y = cvt_pk_bf16(a[2], a[3]); w.z = cvt_pk_bf16(b[0], b[1]); w.w = cvt_pk_bf16(b[2], b[3]); return w; }

template <bool NORM> struct EpiSwiGLU {
    static constexpr bool PERM = true, AFTER_DRAIN = false;
    bf16_t* O; const float* ssq; const float* shw;
    __device__ __forceinline__ void operator()(const f32x4 (&acc)[2][2][4][2], const Unit& u, int wr, int wc, int fr, int fq) const {
        const int row0 = u.pm * BM + wr * 64 + fr, jcol = u.pn * 128 + wc * 32 + 8 * fq;
        f32x4 sg[2], su[2];
        if (NORM) { const float* sp = shw + (size_t)(u.pm >> 3) * 5632 + u.pn * 256 + wc * 32 + 8 * fq;
            sg[0] = *(const f32x4*)(sp); sg[1] = *(const f32x4*)(sp + 4); su[0] = *(const f32x4*)(sp + 128); su[1] = *(const f32x4*)(sp + 132); }
#pragma unroll
        for (int ai = 0; ai < 2; ++ai)
#pragma unroll
            for (int m = 0; m < 4; ++m) { const int row = row0 + ai * HALF + m * 16;
                f32x4 g0 = acc[ai][0][m][0], g1 = acc[ai][0][m][1], u0 = acc[ai][1][m][0], u1 = acc[ai][1][m][1];
                if (NORM) { const float rs = row_rstd(ssq, row, fq); g0 = g0 * rs + sg[0]; g1 = g1 * rs + sg[1]; u0 = u0 * rs + su[0]; u1 = u1 * rs + su[1]; }
                f32x4 o0, o1;
#pragma unroll
                for (int j = 0; j < 4; ++j) { o0[j] = fast_silu(g0[j]) * u0[j]; o1[j] = fast_silu(g1[j]) * u1[j]; }
                *(u32x4*)(O + (size_t)row * 2816 + jcol) = pack8(o0, o1); }
    }
};
template <bool XG, bool HALFC> struct EpiRes {
    static constexpr bool PERM = false, AFTER_DRAIN = false;
    const float* Xin; float* X; const float* gate; bf16_t* XGo; const float* gm; float* ssq;
    __device__ __forceinline__ void operator()(const f32x4 (&acc)[2][2][4][2], const Unit& u, int wr, int wc, int fr, int fq) const {
        const int b = u.pm >> 3, col0 = u.pn * BM + wc * 32 + 4 * fq, row0 = u.pm * BM + wr * 64 + fr;
        f32x4 gv[2][2], gmv[2][2];
#pragma unroll
        for (int bj = 0; bj < 2; ++bj)
#pragma unroll
            for (int n = 0; n < 2; ++n) { gv[bj][n] = *(const f32x4*)(gate + (size_t)b * 9216 + col0 + bj * HALF + n * 16) * (HALFC ? 0.5f : 1.0f);
                if (XG) gmv[bj][n] = *(const f32x4*)(gm + (size_t)b * 1024 + col0 + bj * HALF + n * 16); }
#pragma unroll
        for (int ai = 0; ai < 2; ++ai)
#pragma unroll
            for (int m = 0; m < 4; ++m) { const int row = row0 + ai * HALF + m * 16; const size_t off = (size_t)row * 1024 + col0; float ss = 0.f;
#pragma unroll
                for (int bj = 0; bj < 2; ++bj)
#pragma unroll
                    for (int n = 0; n < 2; ++n) { const f32x4 bs = *(const f32x4*)(Xin + off + bj * HALF + n * 16); const f32x4 o = bs + gv[bj][n] * acc[ai][bj][m][n];
                        *(f32x4*)(X + off + bj * HALF + n * 16) = o; ss += (o[0] * o[0] + o[1] * o[1]) + (o[2] * o[2] + o[3] * o[3]);
                        if (XG) { const f32x4 z = o * gmv[bj][n]; typedef unsigned u32x2v __attribute__((ext_vector_type(2))); u32x2v w; w.x = cvt_pk_bf16(z[0], z[1]); w.y = cvt_pk_bf16(z[2], z[3]);
                            *(u32x2v*)(XGo + off + bj * HALF + n * 16) = w; } }
                ss += __shfl_xor(ss, 16); ss += __shfl_xor(ss, 32);
                if (fq == 0) ssq[(size_t)(u.pn * 4 + wc) * T_ + row] = ss; }
    }
};
struct EpiProj {
    static constexpr bool PERM = true, AFTER_DRAIN = false;
    bf16_t* P; const float* ssq; const float* shw; const float* gq; const float* gk; const float* ropec; const float* ropes;
    __device__ __forceinline__ void operator()(const f32x4 (&acc)[2][2][4][2], const Unit& u, int wr, int wc, int fr, int fq) const {
        const int b = u.pm >> 3, pn = u.pn, row0 = u.pm * BM + wr * 64 + fr;
        const float* sp = shw + (size_t)b * 3088 + pn * 256 + wc * 32 + 8 * fq;
        const bool isq = (pn == 6 || pn == 7), isk = (pn == 8 || pn == 9);
        f32x4 sh[2][2], gv[2][2];
#pragma unroll
        for (int bj = 0; bj < 2; ++bj)
#pragma unroll
            for (int n = 0; n < 2; ++n) { sh[bj][n] = *(const f32x4*)(sp + bj * HALF + 4 * n);
                gv[bj][n] = (isq || isk) ? *(const f32x4*)((isq ? gq : gk) + 32 * bj + 8 * fq + 4 * n) : (f32x4){1.f, 1.f, 1.f, 1.f}; }
        const float osc = (pn == 1 || isq) ? 0.125f : 1.f;
        const int lcol = pn * 256 + 64 * wc + 8 * fq;
#pragma unroll
        for (int ai = 0; ai < 2; ++ai)
#pragma unroll
            for (int m = 0; m < 4; ++m) { const int row = row0 + ai * HALF + m * 16; const float rs = row_rstd(ssq, row, fq);
                f32x4 v[2][2];
#pragma unroll
                for (int bj = 0; bj < 2; ++bj)
#pragma unroll
                    for (int n = 0; n < 2; ++n) v[bj][n] = acc[ai][bj][m][n] * rs + sh[bj][n];
                if (isq || isk) {
                    float ss = 0.f;
#pragma unroll
                    for (int bj = 0; bj < 2; ++bj)
#pragma unroll
                        for (int n = 0; n < 2; ++n) ss += (v[bj][n][0] * v[bj][n][0] + v[bj][n][1] * v[bj][n][1]) + (v[bj][n][2] * v[bj][n][2] + v[bj][n][3] * v[bj][n][3]);
                    ss += __shfl_xor(ss, 16); ss += __shfl_xor(ss, 32);
                    const float r = rsqrtf(ss * (1.0f / 64.0f) + 1e-6f);
#pragma unroll
                    for (int bj = 0; bj < 2; ++bj)
#pragma unroll
                        for (int n = 0; n < 2; ++n) v[bj][n] = v[bj][n] * r * gv[bj][n];
                    const int pos = row & 2047;
                    const f32x4 c0 = *(const f32x4*)(ropec + pos * 8), c1 = *(const f32x4*)(ropec + pos * 8 + 4), s0 = *(const f32x4*)(ropes + pos * 8), s1 = *(const f32x4*)(ropes + pos * 8 + 4);
#pragma unroll
                    for (int n = 0; n < 2; ++n)
#pragma unroll
                        for (int j = 0; j < 4; ++j) { const float mine = v[0][n][j], other = __shfl_xor(mine, 16); const float c = n ? c1[j] : c0[j], s = n ? s1[j] : s0[j];
                            const float rot = (fq == 0) ? (mine * c - other * s) : (mine * c + other * s); v[0][n][j] = (fq < 2) ? rot : mine; }
                }
#pragma unroll
                for (int bj = 0; bj < 2; ++bj) *(u32x4*)(P + (size_t)row * 3072 + lcol + 32 * bj) = pack8(v[bj][0] * osc, v[bj][1] * osc); }
    }
};
template <class Epi, class Sched, bool ALIGN_EPI = false, bool SP2 = false>
__device__ __forceinline__ void gemm_phase(PG8_LAS unsigned char* lds, const Gemm g, const Sched& S, const Epi& E) {
    const int tid = threadIdx.x, wid = __builtin_amdgcn_readfirstlane(tid >> 6), lane = tid & 63, wr = wid >> 2, wc = wid & 3, fr = lane & 15, fq = lane >> 4;
    const int K = g.K, nt = K / BK;
    unsigned voffA[2], voffB[2];
#pragma unroll
    for (int i = 0; i < 2; ++i) { int R, C; stage_rc(tid * 16 + i * 8192, R, C); const int Rb = Epi::PERM ? ((R & ~31) + perm32(R & 31)) : R;
        voffA[i] = (unsigned)(R * K + C) * 2u; voffB[i] = (unsigned)(Rb * K + C) * 2u; }
    const size_t kstep = (size_t)(BK * 2);
    const size_t hstep = (size_t)HALF * K * 2;
    const size_t tstep = 2 * hstep;
    const unsigned ldsw = (unsigned)wid * 1024u;
    const int aoff = lds_byte(wr * 64 + fr, fq * 8), boff = lds_byte(wc * 32 + fr, fq * 8);
#define PG8_SA(b, h) (((b) * 2 + (h)) * HTB)
#define PG8_SB(b, h) ((4 + (b) * 2 + (h)) * HTB)
#define PG8_STAGE(bufoff, gbase, voff) do { _Pragma("unroll") for (int _i = 0; _i < 2; ++_i) \
        __builtin_amdgcn_global_load_lds((const unsigned*)((const char*)(gbase) + (voff)[_i]), (PG8_LAS unsigned*)(lds + (bufoff) + ldsw + _i * 8192), 16, 0, 0); } while (0)
#define PG8_LDA(dst, b, h) do { _Pragma("unroll") for (int m = 0; m < 4; ++m) _Pragma("unroll") for (int k = 0; k < 2; ++k) dst[m][k] = *(const PG8_LAS bf16x8*)(lds + PG8_SA(b, h) + aoff + m * 2048 + k * 1024); } while (0)
#define PG8_LDB(dst, b, h) do { _Pragma("unroll") for (int n = 0; n < 2; ++n) _Pragma("unroll") for (int k = 0; k < 2; ++k) dst[n][k] = *(const PG8_LAS bf16x8*)(lds + PG8_SB(b, h) + boff + n * 2048 + k * 1024); } while (0)
#define PG8_MMA(ai, bj, At, Bt) do { __builtin_amdgcn_s_setprio(1); _Pragma("unroll") for (int m = 0; m < 4; ++m) _Pragma("unroll") for (int n = 0; n < 2; ++n) _Pragma("unroll") for (int k = 0; k < 2; ++k) \
        acc[ai][bj][m][n] = __builtin_amdgcn_mfma_f32_16x16x32_bf16(Bt[n][k], At[m][k], acc[ai][bj][m][n], 0, 0, 0); __builtin_amdgcn_s_setprio(0); } while (0)
#define PG8_WAIT_V(n) asm volatile("s_waitcnt vmcnt(" #n ")" ::: "memory")
#define PG8_WAIT_L(n) asm volatile("s_waitcnt lgkmcnt(" #n ")" ::: "memory")
#define PG8_BAR __builtin_amdgcn_s_barrier()
#define PG8_SCHED __builtin_amdgcn_sched_barrier(0)
    Unit cur, nxt; int ui = 0;
    if (!S.next(0, cur)) return;
    f32x4 acc[2][2][4][2];
#pragma unroll
    for (int a = 0; a < 2; ++a)
#pragma unroll
        for (int b = 0; b < 2; ++b)
#pragma unroll
            for (int m = 0; m < 4; ++m)
#pragma unroll
                for (int n = 0; n < 2; ++n) acc[a][b][m][n] = (f32x4){0.f, 0.f, 0.f, 0.f};
    bf16x8 At[4][2], B0[2][2], B1[2][2];
    const char* cA = (const char*)g.A + (size_t)cur.pm * tstep; const char* cB = (const char*)g.Bt + (size_t)cur.pn * tstep;
    S.a_ready(cur);
    if constexpr (SP2) {
        PG8_STAGE(PG8_SB(0, 0), cB, voffB); PG8_STAGE(PG8_SB(0, 1), cB + hstep, voffB); PG8_STAGE(PG8_SA(0, 0), cA, voffA); PG8_STAGE(PG8_SA(0, 1), cA + hstep, voffA);
        if (wr == 1) PG8_BAR;
        PG8_WAIT_V(2); PG8_BAR;
        PG8_STAGE(PG8_SB(1, 0), cB + kstep, voffB); PG8_STAGE(PG8_SA(1, 0), cA + kstep, voffA); PG8_STAGE(PG8_SB(1, 1), cB + hstep + kstep, voffB);
        PG8_WAIT_V(6); PG8_BAR;
    } else {
        PG8_STAGE(PG8_SB(0, 0), cB, voffB); PG8_STAGE(PG8_SA(0, 0), cA, voffA); PG8_STAGE(PG8_SB(0, 1), cB + hstep, voffB); PG8_STAGE(PG8_SA(0, 1), cA + hstep, voffA);
        if (wr == 1) PG8_BAR;
        PG8_WAIT_V(4); PG8_BAR;
        PG8_STAGE(PG8_SB(1, 0), cB + kstep, voffB); PG8_STAGE(PG8_SA(1, 0), cA + kstep, voffA); PG8_STAGE(PG8_SB(1, 1), cB + hstep + kstep, voffB);
        PG8_WAIT_V(6); PG8_BAR;
    }
    for (;;) {
        const bool has_next = S.next(ui + 1, nxt);
        const char* nA = has_next ? (const char*)g.A + (size_t)nxt.pm * tstep : cA; const char* nB = has_next ? (const char*)g.Bt + (size_t)nxt.pn * tstep : cB;
        for (int t = 0; t < nt; t += 2) {
            const bool last = (t == nt - 2);
            const char* a1 = cA + (size_t)(t + 1) * kstep;
            const char* a2 = last ? nA : cA + (size_t)(t + 2) * kstep; const char* b2 = last ? nB : cB + (size_t)(t + 2) * kstep;
            const char* a3 = a2 + kstep; const char* b3 = b2 + kstep;
            if (last && has_next) S.a_ready(nxt);
            if constexpr (SP2) {
            PG8_LDB(B0, 0, 0); PG8_LDB(B1, 0, 1); PG8_SCHED; PG8_LDA(At, 0, 0); PG8_STAGE(PG8_SA(1, 1), a1 + hstep, voffA);
            PG8_WAIT_V(8); PG8_WAIT_L(0); PG8_BAR; PG8_MMA(0, 0, At, B0); PG8_MMA(0, 1, At, B1); PG8_BAR; PG8_SCHED;
            PG8_LDA(At, 0, 1); PG8_STAGE(PG8_SB(0, 0), b2, voffB); PG8_STAGE(PG8_SB(0, 1), b2 + hstep, voffB); PG8_STAGE(PG8_SA(0, 0), a2, voffA);
            PG8_WAIT_V(8); PG8_WAIT_L(0); PG8_BAR; PG8_MMA(1, 0, At, B0); PG8_MMA(1, 1, At, B1); PG8_BAR; PG8_SCHED;
            PG8_LDB(B0, 1, 0); PG8_LDB(B1, 1, 1); PG8_SCHED; PG8_LDA(At, 1, 0); PG8_STAGE(PG8_SA(0, 1), a2 + hstep, voffA);
            PG8_WAIT_V(8); PG8_WAIT_L(0); PG8_BAR; PG8_MMA(0, 0, At, B0); PG8_MMA(0, 1, At, B1); PG8_BAR; PG8_SCHED;
            PG8_LDA(At, 1, 1); PG8_STAGE(PG8_SB(1, 0), b3, voffB); PG8_STAGE(PG8_SB(1, 1), b3 + hstep, voffB); PG8_STAGE(PG8_SA(1, 0), a3, voffA);
            PG8_WAIT_V(8); PG8_WAIT_L(0); PG8_BAR; PG8_MMA(1, 0, At, B0); PG8_MMA(1, 1, At, B1); PG8_BAR; PG8_SCHED;
            } else {
            PG8_LDB(B0, 0, 0); PG8_SCHED; PG8_LDA(At, 0, 0); PG8_STAGE(PG8_SA(1, 1), a1 + hstep, voffA);
            PG8_WAIT_L(8); PG8_BAR; PG8_WAIT_L(0); PG8_MMA(0, 0, At, B0); PG8_BAR; PG8_SCHED;
            PG8_LDB(B1, 0, 1); PG8_STAGE(PG8_SB(0, 0), b2, voffB);
            PG8_BAR; PG8_WAIT_L(0); PG8_MMA(0, 1, At, B1); PG8_BAR;
            PG8_LDA(At, 0, 1); PG8_STAGE(PG8_SA(0, 0), a2, voffA);
            PG8_BAR; PG8_WAIT_L(0); PG8_MMA(1, 0, At, B0); PG8_BAR; PG8_SCHED;
            PG8_STAGE(PG8_SB(0, 1), b2 + hstep, voffB);
            PG8_WAIT_V(6); PG8_BAR; PG8_MMA(1, 1, At, B1); PG8_BAR;
            PG8_LDB(B0, 1, 0); PG8_SCHED; PG8_LDA(At, 1, 0); PG8_STAGE(PG8_SA(0, 1), a2 + hstep, voffA);
            PG8_WAIT_L(8); PG8_BAR; PG8_WAIT_L(0); PG8_MMA(0, 0, At, B0); PG8_BAR; PG8_SCHED;
            PG8_LDB(B1, 1, 1); PG8_STAGE(PG8_SB(1, 0), b3, voffB);
            PG8_BAR; PG8_WAIT_L(0); PG8_MMA(0, 1, At, B1); PG8_BAR;
            PG8_LDA(At, 1, 1); PG8_STAGE(PG8_SA(1, 0), a3, voffA);
            PG8_BAR; PG8_WAIT_L(0); PG8_MMA(1, 0, At, B0); PG8_BAR; PG8_SCHED;
            PG8_STAGE(PG8_SB(1, 1), b3 + hstep, voffB);
            PG8_WAIT_V(6); PG8_BAR; PG8_MMA(1, 1, At, B1); PG8_BAR;
            }
        }
        if constexpr (ALIGN_EPI) { if (wr == 0) PG8_BAR; }
        if constexpr (!Epi::AFTER_DRAIN) { E(acc, cur, wr, wc, fr, fq); S.done(cur); }
        if (!has_next) break;
#pragma unroll
        for (int a = 0; a < 2; ++a)
#pragma unroll
            for (int b = 0; b < 2; ++b)
#pragma unroll
                for (int m = 0; m < 4; ++m)
#pragma unroll
                    for (int n = 0; n < 2; ++n) acc[a][b][m][n] = (f32x4){0.f, 0.f, 0.f, 0.f};
        cur = nxt; cA = nA; cB = nB; ++ui;
        if constexpr (ALIGN_EPI) { if (wr == 1) PG8_BAR; }
    }
    PG8_WAIT_V(0);
    if constexpr (!ALIGN_EPI) { if (wr == 0) PG8_BAR; }
    PG8_BAR;
    if constexpr (Epi::AFTER_DRAIN) { E.fused(acc, cur, wr, wc, fr, fq, lds, wid, lane); S.done(cur); }
#undef PG8_SA
#undef PG8_SB
#undef PG8_STAGE
#undef PG8_LDA
#undef PG8_LDB
#undef PG8_MMA
#undef PG8_WAIT_V
#undef PG8_WAIT_L
#undef PG8_BAR
#undef PG8_SCHED
}
}
constexpr size_t MiB = 1u << 20;
constexpr size_t WS_CTL = 0, CTL_ZERO_BYTES = 1 * MiB;
constexpr size_t WS_MOD = 1 * MiB;
constexpr size_t WS_GM2 = 2 * MiB, WS_GM3 = WS_GM2 + 65536, WS_ROPEC = WS_GM3 + 65536, WS_ROPES = WS_ROPEC + 65536;
constexpr size_t WS_SHW2 = WS_ROPES + 65536;
constexpr size_t WS_SHW3 = 2 * MiB + 512 * 1024;
constexpr size_t WS_SSQ2 = 3 * MiB, WS_SSQ3 = 5 * MiB, WS_SSQ4 = 7 * MiB;
constexpr size_t WS_GATES = 9 * MiB;
constexpr size_t WS_WGU1 = 12 * MiB, WS_WD1 = 23 * MiB, WS_WIN = 29 * MiB, WS_WOUT = 36 * MiB, WS_WGU2 = 38 * MiB, WS_WD2 = 49 * MiB;
constexpr size_t WS_XA = 56 * MiB;
constexpr size_t WS_R = 120 * MiB;
constexpr size_t WS_XG3 = 296 * MiB;
constexpr size_t WS_MIX = 312 * MiB;
constexpr size_t WS_END = 504 * MiB;
static_assert(WS_SHW2 + 16 * 3088 * 4 <= WS_SHW3 && WS_SHW3 + 16 * 5632 * 4 <= WS_SSQ2 && WS_WIN + (size_t)3088 * 2048 <= WS_WOUT && WS_WD2 + (size_t)1024 * 2816 * 2 <= WS_XA, "ws map");
constexpr int CW_TMO = 0, CW_BAR = 4096;
constexpr int N_BAR_REGIONS = 4;

constexpr int RING_OFF = 0, RING_BYTES = 131072;
constexpr int LDSCTL_OFF = RING_BYTES, MISC_OFF = LDSCTL_OFF + 320;
constexpr int LDS_BYTES = 147456;
constexpr int NWAVES = 8;
#define GAS __attribute__((address_space(1)))
#define LAS __attribute__((address_space(3)))
typedef unsigned short bf16;
typedef unsigned v4u __attribute__((ext_vector_type(4)));
typedef float f32x4 __attribute__((ext_vector_type(4)));
typedef short bf16x8 __attribute__((ext_vector_type(8)));
typedef GAS unsigned gu32;
typedef GAS unsigned long long gu64;
#define RLX_AGENT __ATOMIC_RELAXED, __HIP_MEMORY_SCOPE_AGENT
#define LDS_WAIT() asm volatile("s_waitcnt lgkmcnt(0)" ::: "memory")
#define VM_WAIT() asm volatile("s_waitcnt vmcnt(0)" ::: "memory")
__device__ __forceinline__ unsigned long long rt() { return __builtin_amdgcn_s_memrealtime(); }
__device__ __forceinline__ unsigned f2bf(float f) { unsigned u = __builtin_bit_cast(unsigned, f); return (u + 0x7fffu + ((u >> 16) & 1u)) >> 16; }
__device__ __forceinline__ unsigned pk2(float lo, float hi) { return f2bf(lo) | (f2bf(hi) << 16); }
#define XB_TMO      128
#define XB_XCNT(j)  (256  + 64 * (j))
#define XB_XSUB(j)  (1280 + 64 * (j))
#define XB_XGEN(j)  (2304 + 64 * (j))
#define XB_TOP      3328
#define XB_TOPGEN   3392
#define XCD_BAR_WORDS 3456
#define XB_SPIN_CAP (1u << 18)

__device__ __forceinline__ unsigned xb_ld(unsigned* p)              { return __hip_atomic_load(p, __ATOMIC_RELAXED, __HIP_MEMORY_SCOPE_AGENT); }
__device__ __forceinline__ unsigned xb_add(unsigned* p, unsigned v) { return __hip_atomic_fetch_add(p, v, __ATOMIC_RELAXED, __HIP_MEMORY_SCOPE_AGENT); }
__device__ __forceinline__ unsigned xb_xcc_id() { return (unsigned)__builtin_amdgcn_s_getreg((3 << 11) | 20) & 0xFu; }
#define XB_SPIN(cond, bar) do { unsigned _sp = 0; while (cond) { __builtin_amdgcn_s_sleep(1); \
    if ((++_sp & 255u) == 0u) { if (xb_ld(&(bar)[XB_TMO])) break; if (_sp > XB_SPIN_CAP) { atomicAdd(&(bar)[XB_TMO], 1u); break; } } } } while (0)

struct XcdBarrier {
    unsigned* bar; unsigned x;
    volatile LAS unsigned* st;
};

__device__ __forceinline__ XcdBarrier xcd_barrier_post(unsigned* bar, volatile LAS unsigned* st) {
    XcdBarrier b; b.bar = bar; b.x = xb_xcc_id(); b.st = st;
    if (threadIdx.x == 0) (void)xb_add(&bar[XB_XCNT(b.x)], 1u);
    return b;
}
__device__ __forceinline__ void xcd_barrier_complete(unsigned* bar, unsigned x, unsigned& nloc, unsigned& nx) {
    const unsigned G = gridDim.x * gridDim.y * gridDim.z;
    unsigned sum, cnt, mine, sp = 0u;
    for (;;) {
        sum = 0u; cnt = 0u; mine = 0u;
#pragma unroll
        for (unsigned j = 0; j < 16; ++j) { const unsigned c = xb_ld(&bar[XB_XCNT(j)]); sum += c; cnt += (c > 0u) ? 1u : 0u; mine = (j == x) ? c : mine; }
        if (sum == G) break;
        __builtin_amdgcn_s_sleep(1);
        if ((++sp & 255u) == 0u) { if (xb_ld(&bar[XB_TMO])) break; if (sp > XB_SPIN_CAP) { atomicAdd(&bar[XB_TMO], 1u); break; } }
    }
    nloc = mine > 0u ? mine : 1u; nx = cnt > 0u ? cnt : 1u;
}

__device__ __forceinline__ void xcd_barrier(const XcdBarrier& b) {
    asm volatile("s_waitcnt vmcnt(0)" ::: "memory");
    __syncthreads();
    if (threadIdx.x == 0) {
        unsigned* bar = b.bar;
        __builtin_amdgcn_s_waitcnt(0);
        unsigned nloc = b.st[0], nx = b.st[1];
        if (nloc == 0u) { xcd_barrier_complete(bar, b.x, nloc, nx); b.st[0] = nloc; b.st[1] = nx; }
        const unsigned old = xb_add(&bar[XB_XSUB(b.x)], 1u);
        const unsigned gen = old / nloc;
        if (old + 1u == (gen + 1u) * nloc) {
            __builtin_amdgcn_fence(__ATOMIC_RELEASE, "agent");
            asm volatile("s_waitcnt vmcnt(0)" ::: "memory");
            const unsigned og = xb_add(&bar[XB_TOP], 1u);
            const unsigned tg = og / nx;
            if (og + 1u == (tg + 1u) * nx) xb_add(&bar[XB_TOPGEN], 1u);
            else XB_SPIN(xb_ld(&bar[XB_TOPGEN]) == tg, bar);
            __builtin_amdgcn_fence(__ATOMIC_ACQUIRE, "agent");
            xb_add(&bar[XB_XGEN(b.x)], 1u);
            asm volatile("s_waitcnt vmcnt(0)" ::: "memory");
        } else {
            XB_SPIN(xb_ld(&bar[XB_XGEN(b.x)]) == gen, bar);
            __builtin_amdgcn_fence(__ATOMIC_ACQUIRE, "agent");
            asm volatile("s_waitcnt vmcnt(0)" ::: "memory");
        }
    }
    __syncthreads();
}
struct Frame {
    LAS unsigned char* lds; volatile LAS unsigned* MISC; gu32* ctl;
    int tid, lane, wave, vcu, G;
};
__device__ __forceinline__ float wave_sum(float v) {
#pragma unroll
    for (int o = 1; o < 64; o <<= 1) v += __shfl_xor(v, o);
    return v;
}
__host__ __device__ __forceinline__ int map_gu(int n) { const int bj = n >= 2816 ? 1 : 0, j = n - bj * 2816; return 256 * (j >> 7) + 128 * bj + (j & 127); }
__host__ __device__ __forceinline__ int map_in(int n) { if (n >= 1536 && n < 1552) return 3072 + (n - 1536); const int nn = n >= 1552 ? n - 16 : n; const int tile = nn >> 8, L = nn & 255, wc = L >> 6, bj = (L >> 5) & 1, r = L & 31; return 256 * tile + 128 * bj + 32 * wc + r; }

template <int MAP> __device__ __forceinline__ void p0_transpose_item(const float* W, int K, int N, bf16* WT, LAS float* scr, int item, int lane) {
    const int nblk = (N + 31) / 32, kb = item / nblk, nb = item % nblk, k0 = 64 * kb, n0 = 32 * nb;
    const bool okc = (n0 + (lane & 31)) < N;
#pragma unroll 8
    for (int i = 0; i < 32; ++i) { const int kk = 2 * i + (lane >> 5); scr[kk * 33 + (lane & 31)] = okc ? W[(size_t)(k0 + kk) * N + n0 + (lane & 31)] : 0.f; }
    LDS_WAIT(); asm volatile("" ::: "memory");
    const int c = lane & 7;
#pragma unroll
    for (int j = 0; j < 4; ++j) { const int n = (lane >> 3) + 8 * j; const LAS float* s = scr + (8 * c) * 33 + n;
        v4u o; o.x = pk2(s[0 * 33], s[1 * 33]); o.y = pk2(s[2 * 33], s[3 * 33]); o.z = pk2(s[4 * 33], s[5 * 33]); o.w = pk2(s[6 * 33], s[7 * 33]);
        const int ns = n0 + n;
        if (ns < N) { const int dr = (MAP == 0) ? ns : (MAP == 1 ? map_gu(ns) : map_in(ns)); *(GAS v4u*)(WT + (size_t)dr * K + k0 + 8 * c) = o; } }
    LDS_WAIT(); asm volatile("" ::: "memory");
}
__device__ __forceinline__ void colblock16(Frame& F, const float* W, int ldw, int n0, int nvalid, const float* vec, int vstride, bool silu, float (&r)[2]) {
    LAS float* cs = (LAS float*)(F.lds) + F.wave * 2048;
    LAS float* red = (LAS float*)(F.lds + 65536);
    const int k0 = F.wave * 128;
    for (int e = F.lane; e < 2048; e += 64) { const int b = e >> 7, k = e & 127; float v = vec[(size_t)b * vstride + k0 + k]; if (silu) v = v / (1.f + expf(-v)); cs[e] = v; }
    LDS_WAIT(); asm volatile("" ::: "memory");
    float acc[16];
#pragma unroll
    for (int b = 0; b < 16; ++b) acc[b] = 0.f;
    const bool ok = F.lane < nvalid;
    const float* wp = W + (size_t)k0 * ldw + n0 + (ok ? F.lane : 0);
    for (int k = 0; k < 128; k += 4) {
        const float w0 = wp[(size_t)(k + 0) * ldw], w1 = wp[(size_t)(k + 1) * ldw], w2 = wp[(size_t)(k + 2) * ldw], w3 = wp[(size_t)(k + 3) * ldw];
#pragma unroll
        for (int b = 0; b < 16; ++b) { const f32x4 c4 = *(const LAS f32x4*)(cs + b * 128 + k); acc[b] += (c4[0] * w0 + c4[1] * w1) + (c4[2] * w2 + c4[3] * w3); }
    }
#pragma unroll
    for (int b = 0; b < 16; ++b) red[(F.wave * 16 + b) * 64 + F.lane] = acc[b];
    __syncthreads();
#pragma unroll
    for (int i = 0; i < 2; ++i) { const int e = F.tid + 512 * i; float s = 0.f;
#pragma unroll
        for (int w = 0; w < 8; ++w) s += red[w * 1024 + e];
        r[i] = s; }
    __syncthreads();
}
typedef short s16x4 __attribute__((ext_vector_type(4)));
typedef short v4i16_t __attribute__((ext_vector_type(4)));
typedef unsigned u32x2 __attribute__((ext_vector_type(2)));
__device__ __forceinline__ s16x4 vtr(const LAS unsigned char* p) { return __builtin_bit_cast(s16x4, __builtin_amdgcn_ds_read_tr16_b64_v4i16((LAS v4i16_t*)p)); }
#define MK8(lo, hi) ((bf16x8){lo[0], lo[1], lo[2], lo[3], hi[0], hi[1], hi[2], hi[3]})
__device__ __forceinline__ float bf_lo(unsigned w) { return __uint_as_float(w << 16); }
__device__ __forceinline__ float bf_hi(unsigned w) { return __uint_as_float(w & 0xffff0000u); }
__device__ __forceinline__ bf16x8 pack_p(const f32x4& a, const f32x4& b) { v4u w; w.x = pk2(a[0], a[1]); w.y = pk2(a[2], a[3]); w.z = pk2(b[0], b[1]); w.w = pk2(b[2], b[3]); return __builtin_bit_cast(bf16x8, w); }
constexpr size_t WS_CST = WS_MIX;
constexpr size_t WS_OP = WS_MIX + 64 * MiB;
constexpr size_t WS_LSE = WS_OP + 96 * MiB;
constexpr size_t WS_NST = WS_LSE + 3 * MiB;
constexpr size_t WS_MST = WS_NST + 1 * MiB;
static_assert(WS_MST + 16384 <= WS_END, "mixer scratch");

__device__ __forceinline__ void mlstm_scan_task(Frame& F, const unsigned char* wsb, int task) {
    const int b = task >> 4, h = (task >> 2) & 3, dir = (task >> 1) & 1, vh = task & 1, chain = task >> 1;
    const int lane = F.lane, g = lane >> 4, i = lane & 15;
    LAS float* LI = (LAS float*)(F.lds); LAS float* LF = LI + 2048; LAS float* WG = LF + 2048;
    LAS float* BEND = WG + 2048; LAS float* MGc = BEND + 32; LAS float* MNEXT = MGc + 32; LAS float* DEC = MNEXT + 32;
    LAS unsigned char* KT = F.lds + 28672; LAS unsigned char* VT = KT + 64 * 160;
    const float* GATES = (const float*)(wsb + WS_GATES); const bf16* PROJ = (const bf16*)(wsb + WS_R);
    bf16* CST = (bf16*)(wsb + WS_CST); float* NST = (float*)(wsb + WS_NST); float* MST = (float*)(wsb + WS_MST);
    for (int j = F.tid; j < 2048; j += 512) { const int t = dir ? 2047 - j : j; const float* gp = GATES + (size_t)(b * 2048 + t) * 16; LI[j] = gp[(dir ? 8 : 0) + h]; LF[j] = gp[(dir ? 12 : 4) + h]; }
    __syncthreads();
    for (int c = F.wave; c < 32; c += 8) { float bc = LF[64 * c + lane];
#pragma unroll
        for (int o = 1; o < 64; o <<= 1) { const float tt = __shfl_up(bc, o); if (lane >= o) bc += tt; }
        const float bend = __shfl(bc, 63), gg = bend - bc + LI[64 * c + lane]; float mg = gg;
#pragma unroll
        for (int o = 32; o > 0; o >>= 1) mg = fmaxf(mg, __shfl_xor(mg, o));
        WG[64 * c + lane] = gg; if (lane == 0) { BEND[c] = bend; MGc[c] = mg; } }
    __syncthreads();
    if (F.tid == 0) { float m = -1e30f; for (int c = 0; c < 32; ++c) { const float mn = fmaxf(BEND[c] + m, MGc[c]); DEC[c] = expf(BEND[c] + m - mn); MNEXT[c] = mn; if (vh == 0) MST[chain * 32 + c] = m; m = mn; } }
    __syncthreads();
    for (int j = F.tid; j < 2048; j += 512) WG[j] = expf(WG[j] - MNEXT[j >> 6]);
    const int srow = F.tid >> 3, cc = F.tid & 7;
    const bf16* kbase = PROJ + (size_t)b * 2048 * PW + 256 + h * 64 + cc * 8; const bf16* vbase = PROJ + (size_t)b * 2048 * PW + 512 + h * 128 + vh * 64 + cc * 8;
    v4u kreg, vreg; { const int t = dir ? 2047 - srow : srow; kreg = *(const v4u*)(kbase + (size_t)t * PW); vreg = *(const v4u*)(vbase + (size_t)t * PW); }
    f32x4 acc[2]; acc[0] = (f32x4){0.f, 0.f, 0.f, 0.f}; acc[1] = acc[0]; float nacc = 0.f;
    const int vt = F.wave >> 1, dt0 = (F.wave & 1) * 2;
    const int troff = (8 * g + (i >> 2)) * 160 + 8 * (i & 3);
    __syncthreads();
    for (int c = 0; c < 32; ++c) {
        *(LAS v4u*)(KT + srow * 160 + cc * 16) = kreg;
        { const float w = WG[64 * c + srow]; v4u o; o.x = pk2(bf_lo(vreg.x) * w, bf_hi(vreg.x) * w); o.y = pk2(bf_lo(vreg.y) * w, bf_hi(vreg.y) * w); o.z = pk2(bf_lo(vreg.z) * w, bf_hi(vreg.z) * w); o.w = pk2(bf_lo(vreg.w) * w, bf_hi(vreg.w) * w);
          *(LAS v4u*)(VT + srow * 160 + cc * 16) = o; }
        if (c + 1 < 32) { const int jn = 64 * (c + 1) + srow, t = dir ? 2047 - jn : jn; kreg = *(const v4u*)(kbase + (size_t)t * PW); vreg = *(const v4u*)(vbase + (size_t)t * PW); }
        __syncthreads();
        const float dec = DEC[c];
#pragma unroll
        for (int dd = 0; dd < 2; ++dd) { u32x2 w; w.x = pk2(acc[dd][0], acc[dd][1]); w.y = pk2(acc[dd][2], acc[dd][3]);
            *(u32x2*)(CST + ((size_t)(chain * 32 + c) * 128 + vh * 64 + vt * 16 + i) * 64 + (dt0 + dd) * 16 + 4 * g) = w; acc[dd] = acc[dd] * dec; }
#pragma unroll
        for (int ks = 0; ks < 2; ++ks) {
            const s16x4 bl = vtr(VT + ks * 32 * 160 + troff + 32 * vt), bh = vtr(VT + (ks * 32 + 4) * 160 + troff + 32 * vt); const bf16x8 bfr = MK8(bl, bh);
#pragma unroll
            for (int dd = 0; dd < 2; ++dd) { const s16x4 al = vtr(KT + ks * 32 * 160 + troff + 32 * (dt0 + dd)), ah = vtr(KT + (ks * 32 + 4) * 160 + troff + 32 * (dt0 + dd));
                acc[dd] = __builtin_amdgcn_mfma_f32_16x16x32_bf16(MK8(al, ah), bfr, acc[dd], 0, 0, 0); } }
        if (F.wave == 0 && vh == 0) { NST[(size_t)(chain * 32 + c) * 64 + lane] = nacc; float a = 0.f;
            for (int s = 0; s < 64; ++s) a += WG[64 * c + s] * __uint_as_float((unsigned)(*(const LAS unsigned short*)(KT + s * 160 + lane * 2)) << 16);
            nacc = nacc * dec + a; }
        __syncthreads();
    }
}

__device__ __forceinline__ void attn_units(Frame& F, const unsigned char* wsb) {
    const int lane = F.lane, g = lane >> 4, i = lane & 15, half = F.wave >> 2, w4 = F.wave & 3, t256 = F.tid & 255;
    LAS unsigned char* VL = F.lds + half * 33280;
    const bf16* PROJ = (const bf16*)(wsb + WS_R); bf16* OP = (bf16*)(wsb + WS_OP); float* LSE = (float*)(wsb + WS_LSE);
    for (int e = t256; e < 16 * 10; e += 256) *(LAS v4u*)(VL + 192 * 160 + e * 16) = (v4u){0u, 0u, 0u, 0u};
    for (int it = 0;; ++it) {
        const int U0 = 2 * (it * F.G + F.vcu); if (U0 >= 12288) break;
        const int U = U0 + half, p = U >> 12, rem = U & 4095, bh = rem >> 5, blk = rem & 31, b = bh >> 3, hd = bh & 7;
        const int dsh = 2 * p, r = blk >> (5 - dsh), n = blk & ((32 >> dsh) - 1), L = 2048 >> dsh;
        const bf16* base = PROJ + (size_t)b * 2048 * PW + hd * 64;
#pragma unroll
        for (int e = 0; e < 6; ++e) { const int idx = t256 + 256 * e, kk = idx >> 3, ch = idx & 7, sk = 64 * n - 64 + kk; v4u v = (v4u){0u, 0u, 0u, 0u};
            if (sk >= 0 && sk < L) v = *(const v4u*)(base + (size_t)((sk << dsh) + r) * PW + 2560 + ch * 8);
            *(LAS v4u*)(VL + kk * 160 + ch * 16) = v; }
        __syncthreads();
        const int qi = 16 * w4 + i, tq = ((64 * n + qi) << dsh) + r;
        const bf16* qrow = base + (size_t)tq * PW + 1536; const bf16x8 qf0 = *(const bf16x8*)(qrow + 8 * g), qf1 = *(const bf16x8*)(qrow + 32 + 8 * g);
        f32x4 s[9]; float mx = -1e30f;
#pragma unroll
        for (int tt = 0; tt < 9; ++tt) { const int kk = 16 * (w4 + tt) + i; int sk = 64 * n - 64 + kk; sk = sk < 0 ? 0 : (sk >= L ? L - 1 : sk);
            const bf16* krow = base + (size_t)((sk << dsh) + r) * PW + 2048; const bf16x8 k0 = *(const bf16x8*)(krow + 8 * g), k1 = *(const bf16x8*)(krow + 32 + 8 * g);
            f32x4 a = __builtin_amdgcn_mfma_f32_16x16x32_bf16(k0, qf0, (f32x4){0.f, 0.f, 0.f, 0.f}, 0, 0, 0); a = __builtin_amdgcn_mfma_f32_16x16x32_bf16(k1, qf1, a, 0, 0, 0);
#pragma unroll
            for (int ii = 0; ii < 4; ++ii) { const int kq = 16 * (w4 + tt) + 4 * g + ii, sq = 64 * n - 64 + kq, dl = kq - qi; const bool ok = (dl >= 0) && (dl <= 128) && (sq >= 0) && (sq < L);
                a[ii] = ok ? a[ii] : -1e30f; mx = fmaxf(mx, a[ii]); }
            s[tt] = a; }
        mx = fmaxf(mx, __shfl_xor(mx, 16)); mx = fmaxf(mx, __shfl_xor(mx, 32));
        float l = 0.f;
#pragma unroll
        for (int tt = 0; tt < 9; ++tt)
#pragma unroll
            for (int ii = 0; ii < 4; ++ii) { const float pe = __expf(s[tt][ii] - mx); s[tt][ii] = pe; l += pe; }
        l += __shfl_xor(l, 16); l += __shfl_xor(l, 32);
        f32x4 acc[4];
#pragma unroll
        for (int dv = 0; dv < 4; ++dv) acc[dv] = (f32x4){0.f, 0.f, 0.f, 0.f};
#pragma unroll
        for (int kp = 0; kp < 5; ++kp) { const bf16x8 pf = pack_p(s[2 * kp], kp < 4 ? s[2 * kp + 1] : (f32x4){0.f, 0.f, 0.f, 0.f});
            const LAS unsigned char* va = VL + (16 * (w4 + 2 * kp) + 4 * g + (i >> 2)) * 160 + 8 * (i & 3);
#pragma unroll
            for (int dv = 0; dv < 4; ++dv) { const s16x4 lo = vtr(va + 32 * dv), hi = vtr(va + 16 * 160 + 32 * dv); acc[dv] = __builtin_amdgcn_mfma_f32_16x16x32_bf16(MK8(lo, hi), pf, acc[dv], 0, 0, 0); } }
        const float inv = 1.f / l; const size_t orow = (size_t)p * T + (size_t)b * 2048 + tq;
#pragma unroll
        for (int dv = 0; dv < 4; ++dv) { u32x2 w; w.x = pk2(acc[dv][0] * inv, acc[dv][1] * inv); w.y = pk2(acc[dv][2] * inv, acc[dv][3] * inv); *(u32x2*)(OP + orow * 512 + hd * 64 + 16 * dv + 4 * g) = w; }
        if (g == 0) LSE[orow * 8 + hd] = mx + logf(l);
        __syncthreads();
    }
}

__device__ __forceinline__ void mlstm_out_unit(Frame& F, const unsigned char* wsb, const float* g_mh, int unit) {
    const int co = unit & 31, h = (unit >> 5) & 3, b = unit >> 7;
    const int lane = F.lane, g = lane >> 4, i = lane & 15, dir = F.wave >> 2, w4 = F.wave & 3;
    const int c = dir ? 31 - co : co, chain = (b * 4 + h) * 2 + dir;
    LAS unsigned char* VI = F.lds + dir * 18432;
    LAS float* BC = (LAS float*)(F.lds + 36864) + dir * 128; LAS float* LIc = BC + 64;
    LAS float* HB = (LAS float*)(F.lds + 40960);
    const float* GATES = (const float*)(wsb + WS_GATES); const bf16* PROJ = (const bf16*)(wsb + WS_R);
    const bf16* CST = (const bf16*)(wsb + WS_CST); const float* NST = (const float*)(wsb + WS_NST); const float* MST = (const float*)(wsb + WS_MST);
    bf16* XA = (bf16*)(wsb + WS_XA);
    const size_t rb = (size_t)b * 2048 + 64 * co;
#define TROW(s_) (dir ? 63 - (s_) : (s_))
    { const float* gp = GATES + (rb + TROW(lane)) * 16; const float li = gp[(dir ? 8 : 0) + h]; float bc = gp[(dir ? 12 : 4) + h];
#pragma unroll
      for (int o = 1; o < 64; o <<= 1) { const float tt = __shfl_up(bc, o); if (lane >= o) bc += tt; }
      if (w4 == 0) { BC[lane] = bc; LIc[lane] = li; } }
    { const int t256 = F.tid & 255;
#pragma unroll
      for (int e = 0; e < 4; ++e) { const int idx = t256 + 256 * e, s = idx >> 4, ch = idx & 15; *(LAS v4u*)(VI + s * 288 + ch * 16) = *(const v4u*)(PROJ + (rb + TROW(s)) * PW + 512 + h * 128 + ch * 8); } }
    __syncthreads();
    const int j = 16 * w4 + i;
    const bf16* qrow = PROJ + (rb + TROW(j)) * PW + h * 64; const bf16x8 qf0 = *(const bf16x8*)(qrow + 8 * g), qf1 = *(const bf16x8*)(qrow + 32 + 8 * g);
    f32x4 st[4];
#pragma unroll
    for (int tt = 0; tt < 4; ++tt) { const bf16* krow = PROJ + (rb + TROW(16 * tt + i)) * PW + 256 + h * 64; const bf16x8 k0 = *(const bf16x8*)(krow + 8 * g), k1 = *(const bf16x8*)(krow + 32 + 8 * g);
        f32x4 a = __builtin_amdgcn_mfma_f32_16x16x32_bf16(k0, qf0, (f32x4){0.f, 0.f, 0.f, 0.f}, 0, 0, 0); st[tt] = __builtin_amdgcn_mfma_f32_16x16x32_bf16(k1, qf1, a, 0, 0, 0); }
    const float bj = BC[j], a_int = bj + MST[chain * 32 + c];
    f32x4 dm[4]; float mloc = -1e30f;
#pragma unroll
    for (int tt = 0; tt < 4; ++tt)
#pragma unroll
        for (int ii = 0; ii < 4; ++ii) { const int s = 16 * tt + 4 * g + ii; const float d = (s <= j) ? (bj - BC[s] + LIc[s]) : -1e30f; dm[tt][ii] = d; mloc = fmaxf(mloc, d); }
    mloc = fmaxf(mloc, __shfl_xor(mloc, 16)); mloc = fmaxf(mloc, __shfl_xor(mloc, 32));
    const float m_t = fmaxf(a_int, mloc), w_int = expf(a_int - m_t); float psum = 0.f;
#pragma unroll
    for (int tt = 0; tt < 4; ++tt)
#pragma unroll
        for (int ii = 0; ii < 4; ++ii) { const int s = 16 * tt + 4 * g + ii; const float pv = (s <= j) ? expf(dm[tt][ii] - m_t) * st[tt][ii] : 0.f; st[tt][ii] = pv; psum += pv; }
    psum += __shfl_xor(psum, 16); psum += __shfl_xor(psum, 32);
    f32x4 acc[8];
#pragma unroll
    for (int vt = 0; vt < 8; ++vt) { const bf16* crow = CST + ((size_t)(chain * 32 + c) * 128 + 16 * vt + i) * 64; const bf16x8 c0 = *(const bf16x8*)(crow + 8 * g), c1 = *(const bf16x8*)(crow + 32 + 8 * g);
        f32x4 a = __builtin_amdgcn_mfma_f32_16x16x32_bf16(c0, qf0, (f32x4){0.f, 0.f, 0.f, 0.f}, 0, 0, 0); a = __builtin_amdgcn_mfma_f32_16x16x32_bf16(c1, qf1, a, 0, 0, 0); acc[vt] = a * w_int; }
#pragma unroll
    for (int kp = 0; kp < 2; ++kp) { const bf16x8 pf = pack_p(st[2 * kp], st[2 * kp + 1]);
        const LAS unsigned char* va = VI + (32 * kp + 4 * g + (i >> 2)) * 288 + 8 * (i & 3);
#pragma unroll
        for (int vt = 0; vt < 8; ++vt) { const s16x4 lo = vtr(va + 32 * vt), hi = vtr(va + 16 * 288 + 32 * vt); acc[vt] = __builtin_amdgcn_mfma_f32_16x16x32_bf16(MK8(lo, hi), pf, acc[vt], 0, 0, 0); } }
    float nq = 0.f;
    { const float* np = NST + (size_t)(chain * 32 + c) * 64 + 8 * g; const f32x4 n0 = *(const f32x4*)(np), n1 = *(const f32x4*)(np + 4), n2 = *(const f32x4*)(np + 32), n3 = *(const f32x4*)(np + 36);
      const v4u q0 = __builtin_bit_cast(v4u, qf0), q1 = __builtin_bit_cast(v4u, qf1);
      nq = (n0[0] * bf_lo(q0.x) + n0[1] * bf_hi(q0.x)) + (n0[2] * bf_lo(q0.y) + n0[3] * bf_hi(q0.y)) + (n1[0] * bf_lo(q0.z) + n1[1] * bf_hi(q0.z)) + (n1[2] * bf_lo(q0.w) + n1[3] * bf_hi(q0.w))
         + (n2[0] * bf_lo(q1.x) + n2[1] * bf_hi(q1.x)) + (n2[2] * bf_lo(q1.y) + n2[3] * bf_hi(q1.y)) + (n3[0] * bf_lo(q1.z) + n3[1] * bf_hi(q1.z)) + (n3[2] * bf_lo(q1.w) + n3[3] * bf_hi(q1.w)); }
    nq += __shfl_xor(nq, 16); nq += __shfl_xor(nq, 32);
    const float den = w_int * nq + psum, inv = 1.f / fmaxf(fabsf(den), expf(-m_t));
    if (dir == 1) {
#pragma unroll
        for (int vt = 0; vt < 8; ++vt) *(LAS f32x4*)(HB + (63 - j) * 132 + 16 * vt + 4 * g) = acc[vt] * inv; }
    __syncthreads();
    if (dir == 0) { float ss = 0.f;
#pragma unroll
        for (int vt = 0; vt < 8; ++vt) { const f32x4 hv = acc[vt] * inv + *(const LAS f32x4*)(HB + j * 132 + 16 * vt + 4 * g); acc[vt] = hv; ss += (hv[0] * hv[0] + hv[1] * hv[1]) + (hv[2] * hv[2] + hv[3] * hv[3]); }
        ss += __shfl_xor(ss, 16); ss += __shfl_xor(ss, 32);
        const float rn = rsqrtf(ss * (1.0f / 128.0f) + EPS);
#pragma unroll
        for (int vt = 0; vt < 8; ++vt) { const int col = h * 128 + 16 * vt + 4 * g; const f32x4 gm = *(const f32x4*)(g_mh + col); const u32x2 mo = *(const u32x2*)(PROJ + (rb + j) * PW + 1024 + col);
            const float o0 = acc[vt][0] * rn * gm[0] / (1.f + __expf(-bf_lo(mo.x))), o1 = acc[vt][1] * rn * gm[1] / (1.f + __expf(-bf_hi(mo.x))), o2 = acc[vt][2] * rn * gm[2] / (1.f + __expf(-bf_lo(mo.y))), o3 = acc[vt][3] * rn * gm[3] / (1.f + __expf(-bf_hi(mo.y)));
            u32x2 w; w.x = pk2(o0, o1); w.y = pk2(o2, o3); *(u32x2*)(XA + (rb + j) * D + col) = w; } }
    __syncthreads();
#undef TROW
}
__device__ __forceinline__ void attn_merge(Frame& F, const unsigned char* wsb) {
    const bf16* OP = (const bf16*)(wsb + WS_OP); const float* LSE = (const float*)(wsb + WS_LSE); bf16* XA = (bf16*)(wsb + WS_XA);
    for (int idx = (F.vcu * 512 + F.tid); idx < T * 64; idx += F.G * 512) { const int row = idx >> 6, hd = (idx >> 3) & 7, ch = idx & 7;
        const float l0 = LSE[(size_t)row * 8 + hd], l1 = LSE[((size_t)T + row) * 8 + hd], l2 = LSE[((size_t)2 * T + row) * 8 + hd];
        const float mx = fmaxf(l0, fmaxf(l1, l2)); float w0 = __expf(l0 - mx), w1 = __expf(l1 - mx), w2 = __expf(l2 - mx); const float inv = 1.f / (w0 + w1 + w2); w0 *= inv; w1 *= inv; w2 *= inv;
        const size_t off = (size_t)row * 512 + hd * 64 + ch * 8;
        const v4u a = *(const v4u*)(OP + off), bq = *(const v4u*)(OP + (size_t)T * 512 + off), cq = *(const v4u*)(OP + (size_t)2 * T * 512 + off); v4u o;
        o.x = pk2(w0 * bf_lo(a.x) + w1 * bf_lo(bq.x) + w2 * bf_lo(cq.x), w0 * bf_hi(a.x) + w1 * bf_hi(bq.x) + w2 * bf_hi(cq.x));
        o.y = pk2(w0 * bf_lo(a.y) + w1 * bf_lo(bq.y) + w2 * bf_lo(cq.y), w0 * bf_hi(a.y) + w1 * bf_hi(bq.y) + w2 * bf_hi(cq.y));
        o.z = pk2(w0 * bf_lo(a.z) + w1 * bf_lo(bq.z) + w2 * bf_lo(cq.z), w0 * bf_hi(a.z) + w1 * bf_hi(bq.z) + w2 * bf_hi(cq.z));
        o.w = pk2(w0 * bf_lo(a.w) + w1 * bf_lo(bq.w) + w2 * bf_lo(cq.w), w0 * bf_hi(a.w) + w1 * bf_hi(bq.w) + w2 * bf_hi(cq.w));
        *(v4u*)(XA + (size_t)row * D + 512 + hd * 64 + ch * 8) = o; }
}
__device__ __forceinline__ void normmod_row(int lane, const float* xrow, const float* g, const float* sc, const float* sh, bf16* orow) {
    const GAS f32x4* xr = (const GAS f32x4*)xrow + lane;
    f32x4 v[4]; float s2 = 0.f;
#pragma unroll
    for (int j = 0; j < 4; ++j) { v[j] = xr[64 * j]; s2 += (v[j].x * v[j].x + v[j].y * v[j].y) + (v[j].z * v[j].z + v[j].w * v[j].w); }
    const float rstd = rsqrtf(wave_sum(s2) * (1.f / D) + EPS);
    GAS unsigned long long* o8 = (GAS unsigned long long*)orow + lane;
#pragma unroll
    for (int j = 0; j < 4; ++j) { const f32x4 gg = *((const f32x4*)g + lane + 64 * j), cc = *((const f32x4*)sc + lane + 64 * j), hh = *((const f32x4*)sh + lane + 64 * j);
        const f32x4 o = v[j] * rstd * gg * (cc + 1.0f) + hh;
        o8[64 * j] = (unsigned long long)pk2(o.x, o.y) | ((unsigned long long)pk2(o.z, o.w) << 32); }
}
__device__ __forceinline__ void finalnorm_row(int lane, float* xrow, const float* g) {
    GAS f32x4* xr = (GAS f32x4*)xrow + lane;
    f32x4 v[4]; float s2 = 0.f;
#pragma unroll
    for (int j = 0; j < 4; ++j) { v[j] = xr[64 * j]; s2 += (v[j].x * v[j].x + v[j].y * v[j].y) + (v[j].z * v[j].z + v[j].w * v[j].w); }
    const float rstd = rsqrtf(wave_sum(s2) * (1.f / D) + EPS);
#pragma unroll
    for (int j = 0; j < 4; ++j) xr[64 * j] = v[j] * rstd * *((const f32x4*)g + lane + 64 * j);
}
__device__ __forceinline__ float logsigmoid_f(float x) { return fminf(x, 0.f) - log1pf(expf(-fabsf(x))); }

struct Args { const float* in[18]; float* out; unsigned char* ws; int ph_lo, ph_hi, li, pad; };
constexpr int N_PHASES = 11;
__global__ void __launch_bounds__(NWAVES * 64, 2) mk_fwd(Args args) {
    extern __shared__ __attribute__((aligned(16))) unsigned char lds[];
    Frame F;
    F.lds = (LAS unsigned char*)lds; F.MISC = (volatile LAS unsigned*)(F.lds + MISC_OFF);
    F.tid = threadIdx.x; F.lane = F.tid & 63; F.wave = __builtin_amdgcn_readfirstlane(F.tid >> 6);
    F.G = gridDim.x; { const int bx = blockIdx.x; F.vcu = (F.G % 8 == 0) ? (bx % 8) * (F.G / 8) + bx / 8 : bx; }
    F.ctl = (gu32*)(args.ws + WS_CTL);
#define WSP(type, off) ((type*)(args.ws + (off)))
#define MOD WSP(float, WS_MOD)
#define GM2 WSP(float, WS_GM2)
#define GM3 WSP(float, WS_GM3)
#define ROPEC WSP(float, WS_ROPEC)
#define ROPES WSP(float, WS_ROPES)
#define SHW2 WSP(float, WS_SHW2)
#define SHW3 WSP(float, WS_SHW3)
#define SSQ2 WSP(float, WS_SSQ2)
#define SSQ3 WSP(float, WS_SSQ3)
#define SSQ4 WSP(float, WS_SSQ4)
#define GATES WSP(float, WS_GATES)
#define WGU1 WSP(bf16, WS_WGU1)
#define WD1 WSP(bf16, WS_WD1)
#define WIN WSP(bf16, WS_WIN)
#define WOUT WSP(bf16, WS_WOUT)
#define WGU2 WSP(bf16, WS_WGU2)
#define WD2 WSP(bf16, WS_WD2)
#define XA WSP(bf16, WS_XA)
#define ACT WSP(bf16, WS_R)
#define PROJ WSP(bf16, WS_R)
#define XG3 WSP(bf16, WS_XG3)
#define x_in args.in[0]
#define c_in args.in[1]
#define w_ada args.in[2]
#define b_ada args.in[3]
#define g_ffn1 args.in[4]
#define w_gu1 args.in[5]
#define w_down1 args.in[6]
#define g_mix args.in[7]
#define w_in args.in[8]
#define gate_bias args.in[9]
#define g_q args.in[10]
#define g_k args.in[11]
#define g_mh args.in[12]
#define w_out args.in[13]
#define g_ffn2 args.in[14]
#define w_gu2 args.in[15]
#define w_down2 args.in[16]
#define g_final args.in[17]
#define out args.out
    for (int u = F.tid; u < (LDS_BYTES - LDSCTL_OFF) / 4; u += NWAVES * 64) ((LAS unsigned*)(F.lds + LDSCTL_OFF))[u] = 0u;
    __syncthreads();
    XcdBarrier bar = xcd_barrier_post((unsigned*)(F.ctl + CW_BAR) + args.li * XCD_BAR_WORDS, F.MISC + 8);
    const int lo = args.ph_lo, hi = args.ph_hi, bx = blockIdx.x;
    const int gw = F.vcu * NWAVES + F.wave, NGW = F.G * NWAVES;
#define IN(k) (lo <= (k) && (k) < hi)
#define SEAM(k) do { if ((k) + 1 < hi) xcd_barrier(bar); } while (0)

    if (IN(0)) {
        if (bx < 144) { float r[2]; colblock16(F, w_ada, NMOD * D, 64 * bx, 64, c_in, D, true, r);
#pragma unroll
            for (int i = 0; i < 2; ++i) { const int e = F.tid + 512 * i, b = e >> 6, col = 64 * bx + (e & 63); MOD[(size_t)b * (NMOD * D) + col] = r[i] + b_ada[col]; } }
        { const int gid = bx * 512 + F.tid; if (gid < 16384) { const int pos = gid >> 3, i = gid & 7; const float inv = powf(500000.f, -2.f * (float)i / 16.f), ang = (float)pos * inv; ROPEC[gid] = cosf(ang); ROPES[gid] = sinf(ang); } }
        LAS float* scr = (LAS float*)(F.lds + RING_OFF + F.wave * 16384);
        constexpr int I_GU = 16 * 176, I_DN = 44 * 32, I_IN = 16 * 97, I_OUT = 16 * 32, NITEMS = 2 * I_GU + 2 * I_DN + I_IN + I_OUT;
        for (int it = gw; it < NITEMS; it += NGW) {
            int r = it;
            if (r < I_GU) { p0_transpose_item<1>(w_gu1, D, 2 * DFF, WGU1, scr, r, F.lane); continue; } r -= I_GU;
            if (r < I_GU) { p0_transpose_item<1>(w_gu2, D, 2 * DFF, WGU2, scr, r, F.lane); continue; } r -= I_GU;
            if (r < I_DN) { p0_transpose_item<0>(w_down1, DFF, D, WD1, scr, r, F.lane); continue; } r -= I_DN;
            if (r < I_DN) { p0_transpose_item<0>(w_down2, DFF, D, WD2, scr, r, F.lane); continue; } r -= I_DN;
            if (r < I_IN) { p0_transpose_item<2>(w_in, D, INC, WIN, scr, r, F.lane); continue; } r -= I_IN;
            p0_transpose_item<0>(w_out, D, D, WOUT, scr, r, F.lane);
        }
        SEAM(0);
    }
    if (IN(1)) {
        if (bx < 49) { float r[2]; const int n0 = 64 * bx; colblock16(F, w_in, INC, n0, INC - n0 < 64 ? INC - n0 : 64, MOD + 3 * D, NMOD * D, false, r);
#pragma unroll
            for (int i = 0; i < 2; ++i) { const int e = F.tid + 512 * i, b = e >> 6, n = n0 + (e & 63); if (n < INC) SHW2[(size_t)b * INC + map_in(n)] = r[i]; } }
        else if (bx < 49 + 88) { float r[2]; const int n0 = 64 * (bx - 49); colblock16(F, w_gu2, 2 * DFF, n0, 64, MOD + 6 * D, NMOD * D, false, r);
#pragma unroll
            for (int i = 0; i < 2; ++i) { const int e = F.tid + 512 * i, b = e >> 6, n = n0 + (e & 63); SHW3[(size_t)b * (2 * DFF) + map_gu(n)] = r[i]; } }
        { const int gid = bx * 512 + F.tid; if (gid < 16384) { const int b = gid >> 10, k = gid & 1023; GM2[gid] = g_mix[k] * (1.f + MOD[(size_t)b * (NMOD * D) + 4 * D + k]); GM3[gid] = g_ffn2[k] * (1.f + MOD[(size_t)b * (NMOD * D) + 7 * D + k]); } }
        for (int m = gw; m < T; m += NGW) { const int b = m >> 11; normmod_row(F.lane, x_in + (size_t)m * D, g_ffn1, MOD + (size_t)b * (NMOD * D) + 1 * D, MOD + (size_t)b * (NMOD * D) + 0 * D, XA + (size_t)m * D); }
        SEAM(1);
    }
    if (IN(2)) {
        pg8::Gemm g{XA, WGU1, T, 2 * DFF, D}; pg8::StaticOrder So; So.init(T, 2 * DFF, F.G, bx);
        pg8::EpiSwiGLU<false> E{ACT, nullptr, nullptr};
        pg8::gemm_phase<pg8::EpiSwiGLU<false>, pg8::StaticOrder, true, true>(F.lds + RING_OFF, g, So, E);
        SEAM(2);
    }
    if (IN(3)) {
        pg8::Gemm g{ACT, WD1, T, D, DFF}; pg8::StaticOrder So; So.init(T, D, F.G, bx);
        pg8::EpiRes<true, true> E{x_in, out, MOD + 2 * D, XA, GM2, SSQ2};
        pg8::gemm_phase<pg8::EpiRes<true, true>, pg8::StaticOrder, true, true>(F.lds + RING_OFF, g, So, E);
        SEAM(3);
    }
    if (IN(4)) {
        { const int fr = F.lane & 15, fq = F.lane >> 4;
          for (int rt = gw; rt < T / 16; rt += NGW) {
            const int row = rt * 16 + fr; f32x4 acc = {0.f, 0.f, 0.f, 0.f};
            const bf16* ap = XA + (size_t)row * D + fq * 8; const bf16* bp = WIN + (size_t)(3072 + fr) * D + fq * 8;
#pragma unroll 8
            for (int ks = 0; ks < 32; ++ks) { const bf16x8 a = *(const bf16x8*)(ap + ks * 32), bb = *(const bf16x8*)(bp + ks * 32); acc = __builtin_amdgcn_mfma_f32_16x16x32_bf16(bb, a, acc, 0, 0, 0); }
            const float rs = pg8::row_rstd(SSQ2, row, fq); const int b = row >> 11; f32x4 o;
#pragma unroll
            for (int i = 0; i < 4; ++i) { const int j = 4 * fq + i; float v = acc[i] * rs + SHW2[(size_t)b * INC + 3072 + j] + gate_bias[j]; if (fq & 1) v = logsigmoid_f(v); o[i] = v; }
            *(f32x4*)(GATES + (size_t)row * 16 + 4 * fq) = o; } }
        pg8::Gemm g{XA, WIN, T, PW, D}; pg8::StaticOrder So; So.init(T, PW, F.G, bx);
        pg8::EpiProj E{PROJ, SSQ2, SHW2, g_q, g_k, ROPEC, ROPES};
        pg8::gemm_phase<pg8::EpiProj, pg8::StaticOrder, true, true>(F.lds + RING_OFF, g, So, E);
        SEAM(4);
    }
    if (IN(5)) {
        for (int task = bx; task < 256; task += F.G) mlstm_scan_task(F, args.ws, task);
        attn_units(F, args.ws);
        SEAM(5);
    }
    if (IN(6)) {
        for (int un = F.vcu; un < 2048; un += F.G) mlstm_out_unit(F, args.ws, g_mh, un);
        attn_merge(F, args.ws);
        SEAM(6);
    }
    if (IN(7)) {
        pg8::Gemm g{XA, WOUT, T, D, D}; pg8::StaticOrder So; So.init(T, D, F.G, bx);
        pg8::EpiRes<true, false> E{out, out, MOD + 5 * D, XG3, GM3, SSQ3};
        pg8::gemm_phase<pg8::EpiRes<true, false>, pg8::StaticOrder, true, true>(F.lds + RING_OFF, g, So, E);
        SEAM(7);
    }
    if (IN(8)) {
        pg8::Gemm g{XG3, WGU2, T, 2 * DFF, D}; pg8::StaticOrder So; So.init(T, 2 * DFF, F.G, bx);
        pg8::EpiSwiGLU<true> E{ACT, SSQ3, SHW3};
        pg8::gemm_phase<pg8::EpiSwiGLU<true>, pg8::StaticOrder, true, true>(F.lds + RING_OFF, g, So, E);
        SEAM(8);
    }
    if (IN(9)) {
        pg8::Gemm g{ACT, WD2, T, D, DFF}; pg8::StaticOrder So; So.init(T, D, F.G, bx);
        pg8::EpiRes<false, true> E{out, out, MOD + 8 * D, nullptr, nullptr, SSQ4};
        pg8::gemm_phase<pg8::EpiRes<false, true>, pg8::StaticOrder, true, true>(F.lds + RING_OFF, g, So, E);
        SEAM(9);
    }
    if (IN(10)) { for (int m = gw; m < T; m += NGW) finalnorm_row(F.lane, out + (size_t)m * D, g_final); }
#undef IN
#undef SEAM
}
#undef WSP
#undef MOD
#undef GM2
#undef GM3
#undef ROPEC
#undef ROPES
#undef SHW2
#undef SHW3
#undef SSQ2
#undef SSQ3
#undef SSQ4
#undef GATES
#undef WGU1
#undef WD1
#undef WIN
#undef WOUT
#undef WGU2
#undef WD2
#undef XA
#undef ACT
#undef PROJ
#undef XG3
#undef x_in
#undef c_in
#undef w_ada
#undef b_ada
#undef g_ffn1
#undef w_gu1
#undef w_down1
#undef g_mix
#undef w_in
#undef gate_bias
#undef g_q
#undef g_k
#undef g_mh
#undef w_out
#undef g_ffn2
#undef w_gu2
#undef w_down2
#undef g_final
#undef out
namespace v1 {
__device__ __forceinline__ float bf2f(unsigned short h) { return __uint_as_float(((unsigned)h) << 16); }
__device__ __forceinline__ unsigned short f2bf_(float f) { unsigned u = __float_as_uint(f); return (unsigned short)((u + 0x7fffu + ((u >> 16) & 1u)) >> 16); }
__device__ __forceinline__ float sigmoidf_(float x) { return 1.f / (1.f + expf(-x)); }
__global__ void k_gates(const float* gates, float* LI, float* BC, float* MT) {
    int chain = blockIdx.x * blockDim.x + threadIdx.x; if (chain >= NB * MH * 2) return;
    int dir = chain % 2, h = (chain / 2) % MH, b = chain / (2 * MH);
    float bc = 0.f, pm = -1e30f;
    for (int j = 0; j < S; ++j) { int t = dir ? (S - 1 - j) : j; const float* g = gates + (size_t)(b * S + t) * 16;
        float li = g[(dir ? 8 : 0) + h], lf = g[(dir ? 12 : 4) + h];
        bc += lf; pm = fmaxf(pm, li - bc);
        LI[(size_t)chain * S + j] = li; BC[(size_t)chain * S + j] = bc; MT[(size_t)chain * S + j] = bc + pm; }
}
__global__ void k_mlstm(const bf16* proj, const float* LI, const float* BC, const float* MT, float* H  ) {
    __shared__ float qs[16][65], ks[64][65], vs[64][129], P[16][65];
    int chain = blockIdx.y, dir = chain % 2, h = (chain / 2) % MH, b = chain / (2 * MH);
    int j0 = blockIdx.x * 16; int tid = threadIdx.x;
    const float* li = LI + (size_t)chain * S; const float* bc = BC + (size_t)chain * S; const float* mt = MT + (size_t)chain * S;
    for (int e = tid; e < 16 * 64; e += 256) { int r = e / 64, d = e % 64; int j = j0 + r; int t = dir ? S - 1 - j : j; qs[r][d] = bf2f(proj[(size_t)(b * S + t) * PW + h * 64 + d]); }
    int tq = tid / 16, vg = tid % 16;
    float num[8] = {}; float den = 0.f;
    for (int s0 = 0; s0 <= j0 + 15; s0 += 64) {
        __syncthreads();
        for (int e = tid; e < 64 * 64; e += 256) { int r = e / 64, d = e % 64; int j = s0 + r; float v = 0.f; if (j < S) { int t = dir ? S - 1 - j : j; v = bf2f(proj[(size_t)(b * S + t) * PW + 256 + h * 64 + d]); } ks[r][d] = v; }
        for (int e = tid; e < 64 * 128; e += 256) { int r = e / 128, d = e % 128; int j = s0 + r; float v = 0.f; if (j < S) { int t = dir ? S - 1 - j : j; v = bf2f(proj[(size_t)(b * S + t) * PW + 512 + h * 128 + d]); } vs[r][d] = v; }
        __syncthreads();
        for (int i = 0; i < 4; ++i) { int sl = vg * 4 + i; int js = s0 + sl; int jq = j0 + tq; float p = 0.f;
            if (js <= jq && js < S) { float dot = 0.f; for (int d = 0; d < 64; ++d) dot += qs[tq][d] * ks[sl][d];
                p = expf(bc[jq] - bc[js] + li[js] - mt[jq]) * dot; }
            P[tq][sl] = p; }
        __syncthreads();
        for (int sl = 0; sl < 64; ++sl) { float p = P[tq][sl]; den += p; for (int i = 0; i < 8; ++i) num[i] += p * vs[sl][vg * 8 + i]; }
    }
    int jq = j0 + tq; int t = dir ? S - 1 - jq : jq;
    float dn = fmaxf(fabsf(den), expf(-mt[jq]));
    for (int i = 0; i < 8; ++i) H[((size_t)dir * T + (size_t)(b * S + t)) * 512 + h * 128 + vg * 8 + i] = num[i] / dn;
}
__global__ void k_mlstm_fin(const float* H, const bf16* proj, const float* gmh, bf16* hmix) {
    int w = (blockIdx.x * blockDim.x + threadIdx.x) / 64, lane = threadIdx.x & 63; if (w >= T * MH) return;
    int h = w % MH, t = w / MH;
    float a0 = H[(size_t)t * 512 + h * 128 + lane] + H[((size_t)T + t) * 512 + h * 128 + lane];
    float a1 = H[(size_t)t * 512 + h * 128 + 64 + lane] + H[((size_t)T + t) * 512 + h * 128 + 64 + lane];
    float ss = a0 * a0 + a1 * a1; for (int o = 32; o > 0; o >>= 1) ss += __shfl_xor(ss, o);
    float r = rsqrtf(ss / 128.f + EPS);
    float o0 = bf2f(proj[(size_t)t * PW + 1024 + h * 128 + lane]), o1 = bf2f(proj[(size_t)t * PW + 1024 + h * 128 + 64 + lane]);
    hmix[(size_t)t * D + h * 128 + lane] = f2bf_(a0 * r * gmh[h * 128 + lane] * sigmoidf_(o0));
    hmix[(size_t)t * D + h * 128 + 64 + lane] = f2bf_(a1 * r * gmh[h * 128 + 64 + lane] * sigmoidf_(o1));
}
__global__ void k_attn(const bf16* proj, bf16* hmix) {
    int w = (blockIdx.x * blockDim.x + threadIdx.x) / 64, lane = threadIdx.x & 63; if (w >= T * AH) return;
    int hd = w % AH, tg = w / AH, b = tg / S, t = tg % S;
    float q = bf2f(proj[(size_t)tg * PW + 1536 + hd * AD + lane]);
    float m = -1e30f, l = 0.f, o = 0.f;
    for (int p = 0; p < 3; ++p) { int dil = p == 0 ? 1 : (p == 1 ? 4 : 16);
        for (int j = -64; j <= 64; ++j) { int tk = t + j * dil; if (tk < 0 || tk >= S) continue;
            size_t row = (size_t)(b * S + tk) * PW;
            float s = q * bf2f(proj[row + 2048 + hd * AD + lane]);
            for (int of = 32; of > 0; of >>= 1) s += __shfl_xor(s, of);
            float mn = fmaxf(m, s), f = expf(m - mn), pe = expf(s - mn);
            l = l * f + pe; o = o * f + pe * bf2f(proj[row + 2560 + hd * AD + lane]); m = mn; } }
    hmix[(size_t)tg * D + 512 + hd * AD + lane] = f2bf_(o / l);
}
}

static void launch_mk(Args a, int lo, int hi, int li, int grid, hipStream_t stream) {
    a.ph_lo = lo; a.ph_hi = hi; a.li = li;
    hipLaunchKernelGGL(mk_fwd, dim3(grid), dim3(NWAVES * 64), LDS_BYTES, stream, a);
    const hipError_t le = hipPeekAtLastError();
    if (le != hipSuccess) fprintf(stderr, "kernel_launch: mk_fwd[%d,%d) failed: %s\n", lo, hi, hipGetErrorName(le));
}
extern "C" void kernel_launch(void* const* d_in, const int* in_sizes, int n_in, void* d_out, int out_size, void* d_ws, size_t ws_size, hipStream_t stream) {
    static int grid = 0;
    if (grid == 0) {
        if (n_in != 18 || in_sizes[0] != T * D || out_size != T * D || ws_size < WS_END) { fprintf(stderr, "kernel_launch: unexpected shapes / workspace (n_in %d, ws %zu < %zu); nothing launched\n", n_in, ws_size, (size_t)WS_END); grid = -1; return; }
        int dev = 0, cus = 0;
        if (hipGetDevice(&dev) != hipSuccess || hipDeviceGetAttribute(&cus, hipDeviceAttributeMultiprocessorCount, dev) != hipSuccess) { grid = -1; return; }
        if (hipFuncSetAttribute((const void*)mk_fwd, hipFuncAttributeMaxDynamicSharedMemorySize, LDS_BYTES) != hipSuccess) { fprintf(stderr, "kernel_launch: hipFuncSetAttribute failed\n"); grid = -1; return; }
        (void)hipGetLastError();
        grid = cus;
        if (grid != 256) fprintf(stderr, "kernel_launch: %d CUs (built for 256)\n", grid);
    }
    if (grid < 0) return;
    if (hipMemsetAsync((char*)d_ws + WS_CTL, 0, CTL_ZERO_BYTES, stream) != hipSuccess) return;
    Args a{};
    for (int i = 0; i < 18; ++i) a.in[i] = (const float*)d_in[i];
    a.out = (float*)d_out; a.ws = (unsigned char*)d_ws;
    unsigned char* ws = (unsigned char*)d_ws;
#ifndef MIXER_V1
#define MIXER_V1 0
#endif
#if MIXER_V1
    launch_mk(a, 0, 5, 0, grid, stream);
    {
        const bf16* PROJ = (const bf16*)(ws + WS_R); bf16* XA = (bf16*)(ws + WS_XA); const float* GATES = (const float*)(ws + WS_GATES);
        float* LI = (float*)(ws + WS_MIX); float* BC = LI + (size_t)128 * S; float* MT = BC + (size_t)128 * S; float* H = (float*)(ws + WS_MIX + 64 * MiB);
        v1::k_gates<<<2, 64, 0, stream>>>(GATES, LI, BC, MT);
        v1::k_mlstm<<<dim3(S / 16, NB * MH * 2), 256, 0, stream>>>(PROJ, LI, BC, MT, H);
        v1::k_mlstm_fin<<<(T * MH * 64 + 255) / 256, 256, 0, stream>>>(H, PROJ, (const float*)d_in[12], XA);
        v1::k_attn<<<(T * AH * 64 + 255) / 256, 256, 0, stream>>>(PROJ, XA);
    }
    launch_mk(a, 7, 11, 1, grid, stream);
#else
    launch_mk(a, 0, 11, 0, grid, stream);
#endif
}
```

```cpp
#include <hip/hip_runtime.h>
#include <cstdio>
#include <cstdint>

constexpr int D = 1024, NB = 16, S = 2048, T = NB * S, DFF = 2816, NMOD = 9;
constexpr int MH = 4, MV = 128, MQK = 64, AH = 8, AD = 64, INC = 3088, PW = 3072;
constexpr float EPS = 1e-6f;
namespace pg8 {
#define PG8_LAS __attribute__((address_space(3)))
typedef unsigned short bf16_t;
typedef short bf16x8 __attribute__((ext_vector_type(8)));
typedef float f32x4 __attribute__((ext_vector_type(4)));
typedef unsigned u32x4 __attribute__((ext_vector_type(4)));
constexpr int BM = 256, BK = 64, HALF = 128, HTB = HALF * BK * 2  , STAGE_BYTES = 8 * HTB, NXCD = 8, WGM = 8;

__host__ __device__ __forceinline__ int lds_byte(int r, int c) { const int st = (r >> 4) * 2 + (c >> 5), rr = r & 15, cc = c & 31, ob = rr * 64 + cc * 2; return st * 1024 + (ob ^ (((ob >> 9) & 1) << 5)); }
__host__ __device__ __forceinline__ void stage_rc(int b, int& R, int& C) { const int st = b / 1024, sb = b % 1024, swz = sb ^ (((sb >> 9) & 1) << 5); R = (st >> 1) * 16 + swz / 64; C = (st & 1) * 32 + (swz % 64) / 2; }
__host__ __device__ __forceinline__ int perm32(int rho) { const int n = rho >> 4, i = rho & 15; return 8 * (i >> 2) + 4 * n + (i & 3); }

struct Unit { int pm, pn; };
struct Gemm { const bf16_t* A; const bf16_t* Bt; int M, N, K; };

struct StaticOrder {
    int nM, nN, nwg, G, c;
    __host__ __device__ void init(int M, int N, int G_, int c_) { nM = M / BM; nN = N / BM; nwg = nM * nN; G = G_; c = c_; }
    __host__ __device__ bool next(int i, Unit& u) const {
        const long L = (long)i * G + c; if (L >= nwg) return false;
        int wgid = (int)L; { const int q = nwg / NXCD, r = nwg % NXCD, xcd = wgid % NXCD, off = wgid / NXCD; wgid = (xcd < r ? xcd * (q + 1) : r * (q + 1) + (xcd - r) * q) + off; }
        const int nig = WGM * nN, gid = wgid / nig, fm = gid * WGM, gsz = (nM - fm) < WGM ? (nM - fm) : WGM;
        u.pm = fm + ((wgid % nig) % gsz); u.pn = (wgid % nig) / gsz; return true;
    }
    __device__ __forceinline__ void a_ready(const Unit&) const {}
    __device__ __forceinline__ void done(const Unit&) const {}
};

__device__ __forceinline__ unsigned cvt_pk_bf16(float lo, float hi) { unsigned r; asm volatile("v_cvt_pk_bf16_f32 %0, %1, %2" : "=v"(r) : "v"(lo), "v"(hi)); return r; }
typedef float f32x2 __attribute__((ext_vector_type(2)));
constexpr int T_ = 32768;
__device__ __forceinline__ float fast_silu(float x) { return x * __builtin_amdgcn_rcpf(1.f + __expf(-x)); }
__device__ __forceinline__ float row_rstd(const float* ssq, int row, int fq) {
    float s = 0.f;
#pragma unroll
    for (int i = 0; i < 4; ++i) s += ssq[(size_t)(4 * fq + i) * T_ + row];
    s += __shfl_xor(s, 16); s += __shfl_xor(s, 32);
    return rsqrtf(s * (1.0f / 1024.0f) + 1e-6f);
}
__device__ __forceinline__ u32x4 pack8(const f32x4& a, const f32x4& b) { u32x4 w; w.x = cvt_pk_bf16(a[0], a[1]); w.y = cvt_pk_bf16(a[2], a[3]); w.z = cvt_pk_bf16(b[0], b[1]); w.w = cvt_pk_bf16(b[2], b[3]); return w; }

template <bool NORM> struct EpiSwiGLU {
    static constexpr bool PERM = true, AFTER_DRAIN = false;
    bf16_t* O; const float* ssq; const float* shw;
    __device__ __forceinline__ void operator()(const f32x4 (&acc)[2][2][4][2], const Unit& u, int wr, int wc, int fr, int fq) const {
        const int row0 = u.pm * BM + wr * 64 + fr, jcol = u.pn * 128 + wc * 32 + 8 * fq;
        f32x4 sg[2], su[2];
        if (NORM) { const float* sp = shw + (size_t)(u.pm >> 3) * 5632 + u.pn * 256 + wc * 32 + 8 * fq;
            sg[0] = *(const f32x4*)(sp); sg[1] = *(const f32x4*)(sp + 4); su[0] = *(const f32x4*)(sp + 128); su[1] = *(const f32x4*)(sp + 132); }
#pragma unroll
        for (int ai = 0; ai < 2; ++ai)
#pragma unroll
            for (int m = 0; m < 4; ++m) { const int row = row0 + ai * HALF + m * 16;
                f32x4 g0 = acc[ai][0][m][0], g1 = acc[ai][0][m][1], u0 = acc[ai][1][m][0], u1 = acc[ai][1][m][1];
                if (NORM) { const float rs = row_rstd(ssq, row, fq); g0 = g0 * rs + sg[0]; g1 = g1 * rs + sg[1]; u0 = u0 * rs + su[0]; u1 = u1 * rs + su[1]; }
                f32x4 o0, o1;
#pragma unroll
                for (int j = 0; j < 4; ++j) { o0[j] = fast_silu(g0[j]) * u0[j]; o1[j] = fast_silu(g1[j]) * u1[j]; }
                *(u32x4*)(O + (size_t)row * 2816 + jcol) = pack8(o0, o1); }
    }
};
template <bool XG, bool HALFC> struct EpiRes {
    static constexpr bool PERM = false, AFTER_DRAIN = false;
    const float* Xin; float* X; const float* gate; bf16_t* XGo; const float* gm; float* ssq;
    __device__ __forceinline__ void operator()(const f32x4 (&acc)[2][2][4][2], const Unit& u, int wr, int wc, int fr, int fq) const {
        const int b = u.pm >> 3, col0 = u.pn * BM + wc * 32 + 4 * fq, row0 = u.pm * BM + wr * 64 + fr;
        f32x4 gv[2][2], gmv[2][2];
#pragma unroll
        for (int bj = 0; bj < 2; ++bj)
#pragma unroll
            for (int n = 0; n < 2; ++n) { gv[bj][n] = *(const f32x4*)(gate + (size_t)b * 9216 + col0 + bj * HALF + n * 16) * (HALFC ? 0.5f : 1.0f);
                if (XG) gmv[bj][n] = *(const f32x4*)(gm + (size_t)b * 1024 + col0 + bj * HALF + n * 16); }
#pragma unroll
        for (int ai = 0; ai < 2; ++ai)
#pragma unroll
            for (int m = 0; m < 4; ++m) { const int row = row0 + ai * HALF + m * 16; const size_t off = (size_t)row * 1024 + col0; float ss = 0.f;
#pragma unroll
                for (int bj = 0; bj < 2; ++bj)
#pragma unroll
                    for (int n = 0; n < 2; ++n) { const f32x4 bs = *(const f32x4*)(Xin + off + bj * HALF + n * 16); const f32x4 o = bs + gv[bj][n] * acc[ai][bj][m][n];
                        *(f32x4*)(X + off + bj * HALF + n * 16) = o; ss += (o[0] * o[0] + o[1] * o[1]) + (o[2] * o[2] + o[3] * o[3]);
                        if (XG) { const f32x4 z = o * gmv[bj][n]; typedef unsigned u32x2v __attribute__((ext_vector_type(2))); u32x2v w; w.x = cvt_pk_bf16(z[0], z[1]); w.y = cvt_pk_bf16(z[2], z[3]);
                            *(u32x2v*)(XGo + off + bj * HALF + n * 16) = w; } }
                ss += __shfl_xor(ss, 16); ss += __shfl_xor(ss, 32);
                if (fq == 0) ssq[(size_t)(u.pn * 4 + wc) * T_ + row] = ss; }
    }
};
struct EpiProj {
    static constexpr bool PERM = true, AFTER_DRAIN = false;
    bf16_t* P; const float* ssq; const float* shw; const float* gq; const float* gk; const float* ropec; const float* ropes;
    __device__ __forceinline__ void operator()(const f32x4 (&acc)[2][2][4][2], const Unit& u, int wr, int wc, int fr, int fq) const {
        const int b = u.pm >> 3, pn = u.pn, row0 = u.pm * BM + wr * 64 + fr;
        const float* sp = shw + (size_t)b * 3088 + pn * 256 + wc * 32 + 8 * fq;
        const bool isq = (pn == 6 || pn == 7), isk = (pn == 8 || pn == 9);
        f32x4 sh[2][2], gv[2][2];
#pragma unroll
        for (int bj = 0; bj < 2; ++bj)
#pragma unroll
            for (int n = 0; n < 2; ++n) { sh[bj][n] = *(const f32x4*)(sp + bj * HALF + 4 * n);
                gv[bj][n] = (isq || isk) ? *(const f32x4*)((isq ? gq : gk) + 32 * bj + 8 * fq + 4 * n) : (f32x4){1.f, 1.f, 1.f, 1.f}; }
        const float osc = (pn == 1 || isq) ? 0.125f : 1.f;
        const int lcol = pn * 256 + 64 * wc + 8 * fq;
#pragma unroll
        for (int ai = 0; ai < 2; ++ai)
#pragma unroll
            for (int m = 0; m < 4; ++m) { const int row = row0 + ai * HALF + m * 16; const float rs = row_rstd(ssq, row, fq);
                f32x4 v[2][2];
#pragma unroll
                for (int bj = 0; bj < 2; ++bj)
#pragma unroll
                    for (int n = 0; n < 2; ++n) v[bj][n] = acc[ai][bj][m][n] * rs + sh[bj][n];
                if (isq || isk) {
                    float ss = 0.f;
#pragma unroll
                    for (int bj = 0; bj < 2; ++bj)
#pragma unroll
                        for (int n = 0; n < 2; ++n) ss += (v[bj][n][0] * v[bj][n][0] + v[bj][n][1] * v[bj][n][1]) + (v[bj][n][2] * v[bj][n][2] + v[bj][n][3] * v[bj][n][3]);
                    ss += __shfl_xor(ss, 16); ss += __shfl_xor(ss, 32);
                    const float r = rsqrtf(ss * (1.0f / 64.0f) + 1e-6f);
#pragma unroll
                    for (int bj = 0; bj < 2; ++bj)
#pragma unroll
                        for (int n = 0; n < 2; ++n) v[bj][n] = v[bj][n] * r * gv[bj][n];
                    const int pos = row & 2047;
                    const f32x4 c0 = *(const f32x4*)(ropec + pos * 8), c1 = *(const f32x4*)(ropec + pos * 8 + 4), s0 = *(const f32x4*)(ropes + pos * 8), s1 = *(const f32x4*)(ropes + pos * 8 + 4);
#pragma unroll
                    for (int n = 0; n < 2; ++n)
#pragma unroll
                        for (int j = 0; j < 4; ++j) { const float mine = v[0][n][j], other = __shfl_xor(mine, 16); const float c = n ? c1[j] : c0[j], s = n ? s1[j] : s0[j];
                            const float rot = (fq == 0) ? (mine * c - other * s) : (mine * c + other * s); v[0][n][j] = (fq < 2) ? rot : mine; }
                }
#pragma unroll
                for (int bj = 0; bj < 2; ++bj) *(u32x4*)(P + (size_t)row * 3072 + lcol + 32 * bj) = pack8(v[bj][0] * osc, v[bj][1] * osc); }
    }
};
template <class Epi, class Sched, bool ALIGN_EPI = false, bool SP2 = false>
__device__ __forceinline__ void gemm_phase(PG8_LAS unsigned char* lds, const Gemm g, const Sched& S, const Epi& E) {
    const int tid = threadIdx.x, wid = __builtin_amdgcn_readfirstlane(tid >> 6), lane = tid & 63, wr = wid >> 2, wc = wid & 3, fr = lane & 15, fq = lane >> 4;
    const int K = g.K, nt = K / BK;
    unsigned voffA[2], voffB[2];
#pragma unroll
    for (int i = 0; i < 2; ++i) { int R, C; stage_rc(tid * 16 + i * 8192, R, C); const int Rb = Epi::PERM ? ((R & ~31) + perm32(R & 31)) : R;
        voffA[i] = (unsigned)(R * K + C) * 2u; voffB[i] = (unsigned)(Rb * K + C) * 2u; }
    const size_t kstep = (size_t)(BK * 2);
    const size_t hstep = (size_t)HALF * K * 2;
    const size_t tstep = 2 * hstep;
    const unsigned ldsw = (unsigned)wid * 1024u;
    const int aoff = lds_byte(wr * 64 + fr, fq * 8), boff = lds_byte(wc * 32 + fr, fq * 8);
#define PG8_SA(b, h) (((b) * 2 + (h)) * HTB)
#define PG8_SB(b, h) ((4 + (b) * 2 + (h)) * HTB)
#define PG8_STAGE(bufoff, gbase, voff) do { _Pragma("unroll") for (int _i = 0; _i < 2; ++_i) \
        __builtin_amdgcn_global_load_lds((const unsigned*)((const char*)(gbase) + (voff)[_i]), (PG8_LAS unsigned*)(lds + (bufoff) + ldsw + _i * 8192), 16, 0, 0); } while (0)
#define PG8_LDA(dst, b, h) do { _Pragma("unroll") for (int m = 0; m < 4; ++m) _Pragma("unroll") for (int k = 0; k < 2; ++k) dst[m][k] = *(const PG8_LAS bf16x8*)(lds + PG8_SA(b, h) + aoff + m * 2048 + k * 1024); } while (0)
#define PG8_LDB(dst, b, h) do { _Pragma("unroll") for (int n = 0; n < 2; ++n) _Pragma("unroll") for (int k = 0; k < 2; ++k) dst[n][k] = *(const PG8_LAS bf16x8*)(lds + PG8_SB(b, h) + boff + n * 2048 + k * 1024); } while (0)
#define PG8_MMA(ai, bj, At, Bt) do { __builtin_amdgcn_s_setprio(1); _Pragma("unroll") for (int m = 0; m < 4; ++m) _Pragma("unroll") for (int n = 0; n < 2; ++n) _Pragma("unroll") for (int k = 0; k < 2; ++k) \
        acc[ai][bj][m][n] = __builtin_amdgcn_mfma_f32_16x16x32_bf16(Bt[n][k], At[m][k], acc[ai][bj][m][n], 0, 0, 0); __builtin_amdgcn_s_setprio(0); } while (0)
#define PG8_WAIT_V(n) asm volatile("s_waitcnt vmcnt(" #n ")" ::: "memory")
#define PG8_WAIT_L(n) asm volatile("s_waitcnt lgkmcnt(" #n ")" ::: "memory")
#define PG8_BAR __builtin_amdgcn_s_barrier()
#define PG8_SCHED __builtin_amdgcn_sched_barrier(0)
    Unit cur, nxt; int ui = 0;
    if (!S.next(0, cur)) return;
    f32x4 acc[2][2][4][2];
#pragma unroll
    for (int a = 0; a < 2; ++a)
#pragma unroll
        for (int b = 0; b < 2; ++b)
#pragma unroll
            for (int m = 0; m < 4; ++m)
#pragma unroll
                for (int n = 0; n < 2; ++n) acc[a][b][m][n] = (f32x4){0.f, 0.f, 0.f, 0.f};
    bf16x8 At[4][2], B0[2][2], B1[2][2];
    const char* cA = (const char*)g.A + (size_t)cur.pm * tstep; const char* cB = (const char*)g.Bt + (size_t)cur.pn * tstep;
    S.a_ready(cur);
    if constexpr (SP2) {
        PG8_STAGE(PG8_SB(0, 0), cB, voffB); PG8_STAGE(PG8_SB(0, 1), cB + hstep, voffB); PG8_STAGE(PG8_SA(0, 0), cA, voffA); PG8_STAGE(PG8_SA(0, 1), cA + hstep, voffA);
        if (wr == 1) PG8_BAR;
        PG8_WAIT_V(2); PG8_BAR;
        PG8_STAGE(PG8_SB(1, 0), cB + kstep, voffB); PG8_STAGE(PG8_SA(1, 0), cA + kstep, voffA); PG8_STAGE(PG8_SB(1, 1), cB + hstep + kstep, voffB);
        PG8_WAIT_V(6); PG8_BAR;
    } else {
        PG8_STAGE(PG8_SB(0, 0), cB, voffB); PG8_STAGE(PG8_SA(0, 0), cA, voffA); PG8_STAGE(PG8_SB(0, 1), cB + hstep, voffB); PG8_STAGE(PG8_SA(0, 1), cA + hstep, voffA);
        if (wr == 1) PG8_BAR;
        PG8_WAIT_V(4); PG8_BAR;
        PG8_STAGE(PG8_SB(1, 0), cB + kstep, voffB); PG8_STAGE(PG8_SA(1, 0), cA + kstep, voffA); PG8_STAGE(PG8_SB(1, 1), cB + hstep + kstep, voffB);
        PG8_WAIT_V(6); PG8_BAR;
    }
    for (;;) {
        const bool has_next = S.next(ui + 1, nxt);
        const char* nA = has_next ? (const char*)g.A + (size_t)nxt.pm * tstep : cA; const char* nB = has_next ? (const char*)g.Bt + (size_t)nxt.pn * tstep : cB;
        for (int t = 0; t < nt; t += 2) {
            const bool last = (t == nt - 2);
            const char* a1 = cA + (size_t)(t + 1) * kstep;
            const char* a2 = last ? nA : cA + (size_t)(t + 2) * kstep; const char* b2 = last ? nB : cB + (size_t)(t + 2) * kstep;
            const char* a3 = a2 + kstep; const char* b3 = b2 + kstep;
            if (last && has_next) S.a_ready(nxt);
            if constexpr (SP2) {
            PG8_LDB(B0, 0, 0); PG8_LDB(B1, 0, 1); PG8_SCHED; PG8_LDA(At, 0, 0); PG8_STAGE(PG8_SA(1, 1), a1 + hstep, voffA);
            PG8_WAIT_V(8); PG8_WAIT_L(0); PG8_BAR; PG8_MMA(0, 0, At, B0); PG8_MMA(0, 1, At, B1); PG8_BAR; PG8_SCHED;
            PG8_LDA(At, 0, 1); PG8_STAGE(PG8_SB(0, 0), b2, voffB); PG8_STAGE(PG8_SB(0, 1), b2 + hstep, voffB); PG8_STAGE(PG8_SA(0, 0), a2, voffA);
            PG8_WAIT_V(8); PG8_WAIT_L(0); PG8_BAR; PG8_MMA(1, 0, At, B0); PG8_MMA(1, 1, At, B1); PG8_BAR; PG8_SCHED;
            PG8_LDB(B0, 1, 0); PG8_LDB(B1, 1, 1); PG8_SCHED; PG8_LDA(At, 1, 0); PG8_STAGE(PG8_SA(0, 1), a2 + hstep, voffA);
            PG8_WAIT_V(8); PG8_WAIT_L(0); PG8_BAR; PG8_MMA(0, 0, At, B0); PG8_MMA(0, 1, At, B1); PG8_BAR; PG8_SCHED;
            PG8_LDA(At, 1, 1); PG8_STAGE(PG8_SB(1, 0), b3, voffB); PG8_STAGE(PG8_SB(1, 1), b3 + hstep, voffB); PG8_STAGE(PG8_SA(1, 0), a3, voffA);
            PG8_WAIT_V(8); PG8_WAIT_L(0); PG8_BAR; PG8_MMA(1, 0, At, B0); PG8_MMA(1, 1, At, B1); PG8_BAR; PG8_SCHED;
            } else {
            PG8_LDB(B0, 0, 0); PG8_SCHED; PG8_LDA(At, 0, 0); PG8_STAGE(PG8_SA(1, 1), a1 + hstep, voffA);
            PG8_WAIT_L(8); PG8_BAR; PG8_WAIT_L(0); PG8_MMA(0, 0, At, B0); PG8_BAR; PG8_SCHED;
            PG8_LDB(B1, 0, 1); PG8_STAGE(PG8_SB(0, 0), b2, voffB);
            PG8_BAR; PG8_WAIT_L(0); PG8_MMA(0, 1, At, B1); PG8_BAR;
            PG8_LDA(At, 0, 1); PG8_STAGE(PG8_SA(0, 0), a2, voffA);
            PG8_BAR; PG8_WAIT_L(0); PG8_MMA(1, 0, At, B0); PG8_BAR; PG8_SCHED;
            PG8_STAGE(PG8_SB(0, 1), b2 + hstep, voffB);
            PG8_WAIT_V(6); PG8_BAR; PG8_MMA(1, 1, At, B1); PG8_BAR;
            PG8_LDB(B0, 1, 0); PG8_SCHED; PG8_LDA(At, 1, 0); PG8_STAGE(PG8_SA(0, 1), a2 + hstep, voffA);
            PG8_WAIT_L(8); PG8_BAR; PG8_WAIT_L(0); PG8_MMA(0, 0, At, B0); PG8_BAR; PG8_SCHED;
            PG8_LDB(B1, 1, 1); PG8_STAGE(PG8_SB(1, 0), b3, voffB);
            PG8_BAR; PG8_WAIT_L(0); PG8_MMA(0, 1, At, B1); PG8_BAR;
            PG8_LDA(At, 1, 1); PG8_STAGE(PG8_SA(1, 0), a3, voffA);
            PG8_BAR; PG8_WAIT_L(0); PG8_MMA(1, 0, At, B0); PG8_BAR; PG8_SCHED;
            PG8_STAGE(PG8_SB(1, 1), b3 + hstep, voffB);
            PG8_WAIT_V(6); PG8_BAR; PG8_MMA(1, 1, At, B1); PG8_BAR;
            }
        }
        if constexpr (ALIGN_EPI) { if (wr == 0) PG8_BAR; }
        if constexpr (!Epi::AFTER_DRAIN) { E(acc, cur, wr, wc, fr, fq); S.done(cur); }
        if (!has_next) break;
#pragma unroll
        for (int a = 0; a < 2; ++a)
#pragma unroll
            for (int b = 0; b < 2; ++b)
#pragma unroll
                for (int m = 0; m < 4; ++m)
#pragma unroll
                    for (int n = 0; n < 2; ++n) acc[a][b][m][n] = (f32x4){0.f, 0.f, 0.f, 0.f};
        cur = nxt; cA = nA; cB = nB; ++ui;
        if constexpr (ALIGN_EPI) { if (wr == 1) PG8_BAR; }
    }
    PG8_WAIT_V(0);
    if constexpr (!ALIGN_EPI) { if (wr == 0) PG8_BAR; }
    PG8_BAR;
    if constexpr (Epi::AFTER_DRAIN) { E.fused(acc, cur, wr, wc, fr, fq, lds, wid, lane); S.done(cur); }
#undef PG8_SA
#undef PG8_SB
#undef PG8_STAGE
#undef PG8_LDA
#undef PG8_LDB
#undef PG8_MMA
#undef PG8_WAIT_V
#undef PG8_WAIT_L
#undef PG8_BAR
#undef PG8_SCHED
}
}
constexpr size_t MiB = 1u << 20;
constexpr size_t WS_CTL = 0, CTL_ZERO_BYTES = 1 * MiB;
constexpr size_t WS_MOD = 1 * MiB;
constexpr size_t WS_GM2 = 2 * MiB, WS_GM3 = WS_GM2 + 65536, WS_ROPEC = WS_GM3 + 65536, WS_ROPES = WS_ROPEC + 65536;
constexpr size_t WS_SHW2 = WS_ROPES + 65536;
constexpr size_t WS_SHW3 = 2 * MiB + 512 * 1024;
constexpr size_t WS_SSQ2 = 3 * MiB, WS_SSQ3 = 5 * MiB, WS_SSQ4 = 7 * MiB;
constexpr size_t WS_GATES = 9 * MiB;
constexpr size_t WS_WGU1 = 12 * MiB, WS_WD1 = 23 * MiB, WS_WIN = 29 * MiB, WS_WOUT = 36 * MiB, WS_WGU2 = 38 * MiB, WS_WD2 = 49 * MiB;
constexpr size_t WS_XA = 56 * MiB;
constexpr size_t WS_R = 120 * MiB;
constexpr size_t WS_XG3 = 296 * MiB;
constexpr size_t WS_MIX = 312 * MiB;
constexpr size_t WS_END = 504 * MiB;
static_assert(WS_SHW2 + 16 * 3088 * 4 <= WS_SHW3 && WS_SHW3 + 16 * 5632 * 4 <= WS_SSQ2 && WS_WIN + (size_t)3088 * 2048 <= WS_WOUT && WS_WD2 + (size_t)1024 * 2816 * 2 <= WS_XA, "ws map");
constexpr int CW_TMO = 0, CW_BAR = 4096;
constexpr int N_BAR_REGIONS = 4;

constexpr int RING_OFF = 0, RING_BYTES = 131072;
constexpr int LDS_BYTES = 163840;
constexpr int LDSCTL_OFF = LDS_BYTES - 1024, MISC_OFF = LDSCTL_OFF + 320;
constexpr int NWAVES = 8;
#define GAS __attribute__((address_space(1)))
#define LAS __attribute__((address_space(3)))
typedef unsigned short bf16;
typedef unsigned v4u __attribute__((ext_vector_type(4)));
typedef float f32x4 __attribute__((ext_vector_type(4)));
typedef short bf16x8 __attribute__((ext_vector_type(8)));
typedef GAS unsigned gu32;
typedef GAS unsigned long long gu64;
#define RLX_AGENT __ATOMIC_RELAXED, __HIP_MEMORY_SCOPE_AGENT
#define LDS_WAIT() asm volatile("s_waitcnt lgkmcnt(0)" ::: "memory")
#define VM_WAIT() asm volatile("s_waitcnt vmcnt(0)" ::: "memory")
__device__ __forceinline__ unsigned long long rt() { return __builtin_amdgcn_s_memrealtime(); }
__device__ __forceinline__ unsigned f2bf(float f) { unsigned u = __builtin_bit_cast(unsigned, f); return (u + 0x7fffu + ((u >> 16) & 1u)) >> 16; }
__device__ __forceinline__ unsigned pk2(float lo, float hi) { return f2bf(lo) | (f2bf(hi) << 16); }
#define XB_TMO      128
#define XB_XCNT(j)  (256  + 64 * (j))
#define XB_XSUB(j)  (1280 + 64 * (j))
#define XB_XGEN(j)  (2304 + 64 * (j))
#define XB_TOP      3328
#define XB_TOPGEN   3392
#define XCD_BAR_WORDS 3456
#define XB_SPIN_CAP (1u << 18)

__device__ __forceinline__ unsigned xb_ld(unsigned* p)              { return __hip_atomic_load(p, __ATOMIC_RELAXED, __HIP_MEMORY_SCOPE_AGENT); }
__device__ __forceinline__ unsigned xb_add(unsigned* p, unsigned v) { return __hip_atomic_fetch_add(p, v, __ATOMIC_RELAXED, __HIP_MEMORY_SCOPE_AGENT); }
__device__ __forceinline__ unsigned xb_xcc_id() { return (unsigned)__builtin_amdgcn_s_getreg((3 << 11) | 20) & 0xFu; }
#define XB_SPIN(cond, bar) do { unsigned _sp = 0; while (cond) { __builtin_amdgcn_s_sleep(1); \
    if ((++_sp & 255u) == 0u) { if (xb_ld(&(bar)[XB_TMO])) break; if (_sp > XB_SPIN_CAP) { atomicAdd(&(bar)[XB_TMO], 1u); break; } } } } while (0)

struct XcdBarrier {
    unsigned* bar; unsigned x;
    volatile LAS unsigned* st;
};

__device__ __forceinline__ XcdBarrier xcd_barrier_post(unsigned* bar, volatile LAS unsigned* st) {
    XcdBarrier b; b.bar = bar; b.x = xb_xcc_id(); b.st = st;
    if (threadIdx.x == 0) (void)xb_add(&bar[XB_XCNT(b.x)], 1u);
    return b;
}
__device__ __forceinline__ void xcd_barrier_complete(unsigned* bar, unsigned x, unsigned& nloc, unsigned& nx) {
    const unsigned G = gridDim.x * gridDim.y * gridDim.z;
    unsigned sum, cnt, mine, sp = 0u;
    for (;;) {
        sum = 0u; cnt = 0u; mine = 0u;
#pragma unroll
        for (unsigned j = 0; j < 16; ++j) { const unsigned c = xb_ld(&bar[XB_XCNT(j)]); sum += c; cnt += (c > 0u) ? 1u : 0u; mine = (j == x) ? c : mine; }
        if (sum == G) break;
        __builtin_amdgcn_s_sleep(1);
        if ((++sp & 255u) == 0u) { if (xb_ld(&bar[XB_TMO])) break; if (sp > XB_SPIN_CAP) { atomicAdd(&bar[XB_TMO], 1u); break; } }
    }
    nloc = mine > 0u ? mine : 1u; nx = cnt > 0u ? cnt : 1u;
}

__device__ __forceinline__ void xcd_barrier(const XcdBarrier& b) {
    asm volatile("s_waitcnt vmcnt(0)" ::: "memory");
    __syncthreads();
    if (threadIdx.x == 0) {
        unsigned* bar = b.bar;
        __builtin_amdgcn_s_waitcnt(0);
        unsigned nloc = b.st[0], nx = b.st[1];
        if (nloc == 0u) { xcd_barrier_complete(bar, b.x, nloc, nx); b.st[0] = nloc; b.st[1] = nx; }
        const unsigned old = xb_add(&bar[XB_XSUB(b.x)], 1u);
        const unsigned gen = old / nloc;
        if (old + 1u == (gen + 1u) * nloc) {
            __builtin_amdgcn_fence(__ATOMIC_RELEASE, "agent");
            asm volatile("s_waitcnt vmcnt(0)" ::: "memory");
            const unsigned og = xb_add(&bar[XB_TOP], 1u);
            const unsigned tg = og / nx;
            if (og + 1u == (tg + 1u) * nx) xb_add(&bar[XB_TOPGEN], 1u);
            else XB_SPIN(xb_ld(&bar[XB_TOPGEN]) == tg, bar);
            __builtin_amdgcn_fence(__ATOMIC_ACQUIRE, "agent");
            xb_add(&bar[XB_XGEN(b.x)], 1u);
            asm volatile("s_waitcnt vmcnt(0)" ::: "memory");
        } else {
            XB_SPIN(xb_ld(&bar[XB_XGEN(b.x)]) == gen, bar);
            __builtin_amdgcn_fence(__ATOMIC_ACQUIRE, "agent");
            asm volatile("s_waitcnt vmcnt(0)" ::: "memory");
        }
    }
    __syncthreads();
}
struct Frame {
    LAS unsigned char* lds; volatile LAS unsigned* MISC; gu32* ctl;
    int tid, lane, wave, vcu, G;
};
__device__ __forceinline__ float wave_sum(float v) {
#pragma unroll
    for (int o = 1; o < 64; o <<= 1) v += __shfl_xor(v, o);
    return v;
}
__host__ __device__ __forceinline__ int map_gu(int n) { const int bj = n >= 2816 ? 1 : 0, j = n - bj * 2816; return 256 * (j >> 7) + 128 * bj + (j & 127); }
__host__ __device__ __forceinline__ int map_in(int n) { if (n >= 1536 && n < 1552) return 3072 + (n - 1536); const int nn = n >= 1552 ? n - 16 : n; const int tile = nn >> 8, L = nn & 255, wc = L >> 6, bj = (L >> 5) & 1, r = L & 31; return 256 * tile + 128 * bj + 32 * wc + r; }

template <int MAP> __device__ __forceinline__ void p0_transpose_item(const float* W, int K, int N, bf16* WT, int item, int lane) {
    const int nblk = (N + 63) / 64, kb = item / nblk, nb = item % nblk;
    const int n = nb * 64 + 4 * (lane & 15), k = kb * 32 + 8 * (lane >> 4);
    if (n < N) {
        f32x4 r[8];
#pragma unroll
        for (int j = 0; j < 8; ++j) r[j] = *(const f32x4*)(W + (size_t)(k + j) * N + n);
#pragma unroll
        for (int q = 0; q < 4; ++q) { v4u o; o.x = pk2(r[0][q], r[1][q]); o.y = pk2(r[2][q], r[3][q]); o.z = pk2(r[4][q], r[5][q]); o.w = pk2(r[6][q], r[7][q]);
            const int ns = n + q, dr = (MAP == 0) ? ns : (MAP == 1 ? map_gu(ns) : map_in(ns)); *(GAS v4u*)(WT + (size_t)dr * K + k) = o; }
    }
}
__device__ __forceinline__ void colblock16(Frame& F, const float* W, int ldw, int n0, int nvalid, const float* vec, int vstride, bool silu, float& r0, float& r1) {
    LAS float* cs = (LAS float*)(F.lds) + F.wave * 2048;
    LAS float* red = (LAS float*)(F.lds + 65536);
    const int k0 = F.wave * 128, g = F.lane >> 4, i16 = F.lane & 15;
    { float tv[32];
#pragma unroll
      for (int q = 0; q < 32; ++q) { const int e = F.lane + 64 * q, b = e & 15, k = e >> 4; tv[q] = vec[(size_t)b * vstride + k0 + k]; }
#pragma unroll
      for (int q = 0; q < 32; ++q) { float v = tv[q]; if (silu) v = v / (1.f + __expf(-v)); cs[F.lane + 64 * q] = v; } }
    LDS_WAIT(); asm volatile("" ::: "memory");
    f32x4 acc[4];
#pragma unroll
    for (int t = 0; t < 4; ++t) acc[t] = (f32x4){0.f, 0.f, 0.f, 0.f};
    const float* wp = W + (size_t)(k0 + g) * ldw + n0 + ((4 * i16 < nvalid) ? 4 * i16 : 0);
#pragma unroll 1
    for (int ks = 0; ks < 32; ks += 16) {
        f32x4 w[16];
#pragma unroll
        for (int q = 0; q < 16; ++q) w[q] = *(const f32x4*)(wp + (size_t)(4 * (ks + q)) * ldw);
        __builtin_amdgcn_sched_barrier(0);
#pragma unroll
        for (int q = 0; q < 16; ++q) { const float a = cs[(4 * (ks + q) + g) * 16 + i16];
#pragma unroll
            for (int t = 0; t < 4; ++t) acc[t] = __builtin_amdgcn_mfma_f32_16x16x4f32(a, w[q][t], acc[t], 0, 0, 0); }
    }
#pragma unroll
    for (int ii = 0; ii < 4; ++ii) *(LAS f32x4*)(red + (F.wave * 16 + 4 * g + ii) * 64 + 4 * i16) = (f32x4){acc[0][ii], acc[1][ii], acc[2][ii], acc[3][ii]};
    __syncthreads();
    { float s0 = 0.f, s1 = 0.f;
#pragma unroll
      for (int w = 0; w < 8; ++w) { s0 += red[w * 1024 + F.tid]; s1 += red[w * 1024 + F.tid + 512]; }
      r0 = s0; r1 = s1; }
    __syncthreads();
}
typedef short s16x4 __attribute__((ext_vector_type(4)));
typedef short v4i16_t __attribute__((ext_vector_type(4)));
typedef unsigned u32x2 __attribute__((ext_vector_type(2)));
__device__ __forceinline__ s16x4 vtr(const LAS unsigned char* p) { return __builtin_bit_cast(s16x4, __builtin_amdgcn_ds_read_tr16_b64_v4i16((LAS v4i16_t*)p)); }
#define MK8(lo, hi) ((bf16x8){lo[0], lo[1], lo[2], lo[3], hi[0], hi[1], hi[2], hi[3]})
__device__ __forceinline__ float bf_lo(unsigned w) { return __uint_as_float(w << 16); }
__device__ __forceinline__ float bf_hi(unsigned w) { return __uint_as_float(w & 0xffff0000u); }
__device__ __forceinline__ bf16x8 pack_p(const f32x4& a, const f32x4& b) { v4u w; w.x = pk2(a[0], a[1]); w.y = pk2(a[2], a[3]); w.z = pk2(b[0], b[1]); w.w = pk2(b[2], b[3]); return __builtin_bit_cast(bf16x8, w); }
constexpr size_t WS_CST = WS_MIX;
constexpr size_t WS_OP = WS_MIX + 64 * MiB;
constexpr size_t WS_LSE = WS_OP + 96 * MiB;
constexpr size_t WS_NST = WS_LSE + 3 * MiB;
constexpr size_t WS_MST = WS_NST + 1 * MiB;
static_assert(WS_MST + 16384 <= WS_END, "mixer scratch");

__device__ __forceinline__ void mlstm_scan_task(Frame& F, const unsigned char* wsb, int task) {
    const int b = task >> 4, h = (task >> 2) & 3, dir = (task >> 1) & 1, vh = task & 1, chain = task >> 1;
    const int lane = F.lane, g = lane >> 4, i = lane & 15;
    LAS float* LI = (LAS float*)(F.lds); LAS float* LF = LI + 2048; LAS float* WG = LF + 2048;
    LAS float* BEND = WG + 2048; LAS float* MGc = BEND + 32; LAS float* MNEXT = MGc + 32; LAS float* DEC = MNEXT + 32;
    LAS unsigned char* KT = F.lds + 28672; LAS unsigned char* VT = KT + 64 * 160;
    const float* GATES = (const float*)(wsb + WS_GATES); const bf16* PROJ = (const bf16*)(wsb + WS_R);
    bf16* CST = (bf16*)(wsb + WS_CST); float* NST = (float*)(wsb + WS_NST); float* MST = (float*)(wsb + WS_MST);
    { float gl[4], gf[4];
#pragma unroll
      for (int q = 0; q < 4; ++q) { const int j = F.tid + 512 * q, t = dir ? 2047 - j : j; const float* gp = GATES + (size_t)(b * 2048 + t) * 16; gl[q] = gp[(dir ? 8 : 0) + h]; gf[q] = gp[(dir ? 12 : 4) + h]; }
#pragma unroll
      for (int q = 0; q < 4; ++q) { LI[F.tid + 512 * q] = gl[q]; LF[F.tid + 512 * q] = gf[q]; } }
    __syncthreads();
    for (int c = F.wave; c < 32; c += 8) { float bc = LF[64 * c + lane];
#pragma unroll
        for (int o = 1; o < 64; o <<= 1) { const float tt = __shfl_up(bc, o); if (lane >= o) bc += tt; }
        const float bend = __shfl(bc, 63), gg = bend - bc + LI[64 * c + lane]; float mg = gg;
#pragma unroll
        for (int o = 32; o > 0; o >>= 1) mg = fmaxf(mg, __shfl_xor(mg, o));
        WG[64 * c + lane] = gg; if (lane == 0) { BEND[c] = bend; MGc[c] = mg; } }
    __syncthreads();
    if (F.tid == 0) { float m = -1e30f; for (int c = 0; c < 32; ++c) { const float mn = fmaxf(BEND[c] + m, MGc[c]); DEC[c] = expf(BEND[c] + m - mn); MNEXT[c] = mn; if (vh == 0) MST[chain * 32 + c] = m; m = mn; } }
    __syncthreads();
    for (int j = F.tid; j < 2048; j += 512) WG[j] = expf(WG[j] - MNEXT[j >> 6]);
    const int srow = F.tid >> 3, cc = F.tid & 7;
    const bf16* kbase = PROJ + (size_t)b * 2048 * PW + 256 + h * 64 + cc * 8; const bf16* vbase = PROJ + (size_t)b * 2048 * PW + 512 + h * 128 + vh * 64 + cc * 8;
    v4u kreg[4], vreg[4];
#pragma unroll
    for (int pf = 0; pf < 4; ++pf) { const int jn = 64 * pf + srow, t = dir ? 2047 - jn : jn; kreg[pf] = *(const v4u*)(kbase + (size_t)t * PW); vreg[pf] = *(const v4u*)(vbase + (size_t)t * PW); }
    f32x4 acc[2]; acc[0] = (f32x4){0.f, 0.f, 0.f, 0.f}; acc[1] = acc[0]; f32x4 nacc4 = acc[0];
    const int vt = F.wave >> 1, dt0 = (F.wave & 1) * 2;
    const int troff = (8 * g + (i >> 2)) * 160 + 8 * (i & 3);
    __syncthreads();
    for (int c4 = 0; c4 < 32; c4 += 4) {
#pragma unroll
      for (int cu = 0; cu < 4; ++cu) { const int c = c4 + cu;
        *(LAS v4u*)(KT + srow * 160 + cc * 16) = kreg[cu];
        { const float w = WG[64 * c + srow]; const v4u vv = vreg[cu]; v4u o; o.x = pk2(bf_lo(vv.x) * w, bf_hi(vv.x) * w); o.y = pk2(bf_lo(vv.y) * w, bf_hi(vv.y) * w); o.z = pk2(bf_lo(vv.z) * w, bf_hi(vv.z) * w); o.w = pk2(bf_lo(vv.w) * w, bf_hi(vv.w) * w);
          *(LAS v4u*)(VT + srow * 160 + cc * 16) = o; }
        if (c + 4 < 32) { const int jn = 64 * (c + 4) + srow, t = dir ? 2047 - jn : jn; kreg[cu] = *(const v4u*)(kbase + (size_t)t * PW); vreg[cu] = *(const v4u*)(vbase + (size_t)t * PW); }
        __syncthreads();
        const float dec = DEC[c];
#pragma unroll
        for (int dd = 0; dd < 2; ++dd) { u32x2 w; w.x = pk2(acc[dd][0], acc[dd][1]); w.y = pk2(acc[dd][2], acc[dd][3]);
            *(u32x2*)(CST + ((size_t)(chain * 32 + c) * 128 + vh * 64 + vt * 16 + i) * 64 + (dt0 + dd) * 16 + 4 * g) = w; acc[dd] = acc[dd] * dec; }
#pragma unroll
        for (int ks = 0; ks < 2; ++ks) {
            const s16x4 bl = vtr(VT + ks * 32 * 160 + troff + 32 * vt), bh = vtr(VT + (ks * 32 + 4) * 160 + troff + 32 * vt); const bf16x8 bfr = MK8(bl, bh);
#pragma unroll
            for (int dd = 0; dd < 2; ++dd) { const s16x4 al = vtr(KT + ks * 32 * 160 + troff + 32 * (dt0 + dd)), ah = vtr(KT + (ks * 32 + 4) * 160 + troff + 32 * (dt0 + dd));
                acc[dd] = __builtin_amdgcn_mfma_f32_16x16x32_bf16(MK8(al, ah), bfr, acc[dd], 0, 0, 0); } }
        if (F.wave < 4) {
            if (i == 0 && vh == 0) *(f32x4*)(NST + (size_t)(chain * 32 + c) * 64 + 16 * F.wave + 4 * g) = nacc4;
            nacc4 = nacc4 * dec;
#pragma unroll
            for (int ks = 0; ks < 2; ++ks) { const f32x4 w0 = *(const LAS f32x4*)(WG + 64 * c + 32 * ks + 8 * g), w1 = *(const LAS f32x4*)(WG + 64 * c + 32 * ks + 8 * g + 4);
                const bf16x8 wf = (i == 0) ? pack_p(w0, w1) : (bf16x8){0, 0, 0, 0, 0, 0, 0, 0};
                const s16x4 al = vtr(KT + ks * 32 * 160 + troff + 32 * F.wave), ah = vtr(KT + (ks * 32 + 4) * 160 + troff + 32 * F.wave);
                nacc4 = __builtin_amdgcn_mfma_f32_16x16x32_bf16(MK8(al, ah), wf, nacc4, 0, 0, 0); } }
        __syncthreads();
      }
    }
}

constexpr int AT_KB = 256 * 144, AT_VB = 272 * 144, AT_BUF = AT_KB + AT_VB;
static_assert(2 * AT_BUF <= LDSCTL_OFF, "attention LDS");
struct AtUnit { int p, b, hd, dsh, r, n, L; };
__device__ __forceinline__ AtUnit at_decode(int U) { AtUnit u; u.p = U >> 11; const int rem = U & 2047, bh = rem >> 4, blk = rem & 15; u.b = bh >> 3; u.hd = bh & 7; u.dsh = 2 * u.p;
    u.r = blk >> (4 - u.dsh); u.n = blk & ((16 >> u.dsh) - 1); u.L = 2048 >> u.dsh; return u; }
struct AtRegs { v4u k[4], v[4]; bf16x8 q0, q1; unsigned okm; };
__device__ __forceinline__ void at_load(AtRegs& R, const AtUnit& u, const bf16* PROJ, int tid, int w8, int g, int i) {
    const char* base = (const char*)(PROJ + (size_t)u.b * 2048 * PW + u.hd * 64);
    const int kk0 = tid >> 3, ch = tid & 7; R.okm = 0u;
#pragma unroll
    for (int e = 0; e < 4; ++e) { const int sk = 128 * u.n - 64 + kk0 + 64 * e; const bool ok = (sk >= 0) && (sk < u.L); const int skc = ok ? sk : 0; R.okm |= ok ? (1u << e) : 0u;
        const unsigned off = (unsigned)(((skc << u.dsh) + u.r) * (PW * 2) + ch * 16);
        R.k[e] = *(const v4u*)(base + off + 2048 * 2); R.v[e] = *(const v4u*)(base + off + 2560 * 2); }
    const unsigned qoff = (unsigned)((((128 * u.n + 16 * w8 + i) << u.dsh) + u.r) * (PW * 2) + 1536 * 2 + 16 * g);
    R.q0 = *(const bf16x8*)(base + qoff); R.q1 = *(const bf16x8*)(base + qoff + 64);
}
__device__ __forceinline__ void at_store(const AtRegs& R, LAS unsigned char* buf, int tid) {
    const int kk0 = tid >> 3, ch = tid & 7;
#pragma unroll
    for (int e = 0; e < 4; ++e) { const bool ok = (R.okm >> e) & 1u; const v4u z = (v4u){0u, 0u, 0u, 0u};
        *(LAS v4u*)(buf + (kk0 + 64 * e) * 144 + ch * 16) = ok ? R.k[e] : z; *(LAS v4u*)(buf + AT_KB + (kk0 + 64 * e) * 144 + ch * 16) = ok ? R.v[e] : z; }
}
__device__ __forceinline__ void at_compute(const AtUnit& u, const bf16x8 qf0, const bf16x8 qf1, const LAS unsigned char* buf, bf16* OP, float* LSE, int w8, int g, int i) {
    const LAS unsigned char* KL = buf; const LAS unsigned char* VL = buf + AT_KB;
    const int lo = (u.n == 0) ? 64 : 0, hi = (128 * (u.n + 1) + 64 > u.L) ? (u.L - 128 * u.n + 64) : 256;
    f32x4 s[9]; float mx = -1e30f;
#pragma unroll
    for (int tt = 0; tt < 9; ++tt) { const LAS unsigned char* kp = KL + (16 * (w8 + tt) + i) * 144 + 16 * g;
        const bf16x8 k0 = *(const LAS bf16x8*)(kp), k1 = *(const LAS bf16x8*)(kp + 64);
        f32x4 a = __builtin_amdgcn_mfma_f32_16x16x32_bf16(k0, qf0, (f32x4){0.f, 0.f, 0.f, 0.f}, 0, 0, 0); a = __builtin_amdgcn_mfma_f32_16x16x32_bf16(k1, qf1, a, 0, 0, 0);
#pragma unroll
        for (int ii = 0; ii < 4; ++ii) { const int kq = 16 * (w8 + tt) + 4 * g + ii; bool ok = (kq >= lo) && (kq < hi);
            if (tt == 0) ok = ok && (4 * g + ii >= i); if (tt == 8) ok = ok && (4 * g + ii <= i);
            a[ii] = ok ? a[ii] : -1e30f; mx = fmaxf(mx, a[ii]); }
        s[tt] = a; }
    mx = fmaxf(mx, __shfl_xor(mx, 16)); mx = fmaxf(mx, __shfl_xor(mx, 32));
    float l = 0.f;
#pragma unroll
    for (int tt = 0; tt < 9; ++tt)
#pragma unroll
        for (int ii = 0; ii < 4; ++ii) { const float pe = __expf(s[tt][ii] - mx); s[tt][ii] = pe; l += pe; }
    l += __shfl_xor(l, 16); l += __shfl_xor(l, 32);
    f32x4 acc[4];
#pragma unroll
    for (int dv = 0; dv < 4; ++dv) acc[dv] = (f32x4){0.f, 0.f, 0.f, 0.f};
#pragma unroll
    for (int kp = 0; kp < 5; ++kp) { const bf16x8 pf = pack_p(s[2 * kp], kp < 4 ? s[2 * kp + 1] : (f32x4){0.f, 0.f, 0.f, 0.f});
        const LAS unsigned char* va = VL + (16 * (w8 + 2 * kp) + 4 * g + (i >> 2)) * 144 + 8 * (i & 3);
#pragma unroll
        for (int dv = 0; dv < 4; ++dv) { const s16x4 lo4 = vtr(va + 32 * dv), hi4 = vtr(va + 16 * 144 + 32 * dv); acc[dv] = __builtin_amdgcn_mfma_f32_16x16x32_bf16(MK8(lo4, hi4), pf, acc[dv], 0, 0, 0); } }
    const float inv = 1.f / l; const int tq = ((128 * u.n + 16 * w8 + i) << u.dsh) + u.r; const size_t orow = (size_t)u.p * T + (size_t)u.b * 2048 + tq;
#pragma unroll
    for (int dv = 0; dv < 4; ++dv) { u32x2 w; w.x = pk2(acc[dv][0] * inv, acc[dv][1] * inv); w.y = pk2(acc[dv][2] * inv, acc[dv][3] * inv); *(u32x2*)(OP + orow * 512 + u.hd * 64 + 16 * dv + 4 * g) = w; }
    if (g == 0) LSE[orow * 8 + u.hd] = mx + __logf(l);
}
__device__ __forceinline__ void attn_units(Frame& F, const unsigned char* wsb) {
    const int lane = F.lane, g = lane >> 4, i = lane & 15, w8 = F.wave;
    const bf16* PROJ = (const bf16*)(wsb + WS_R); bf16* OP = (bf16*)(wsb + WS_OP); float* LSE = (float*)(wsb + WS_LSE);
    for (int e = F.tid; e < 2 * 144; e += 512) *(LAS v4u*)(F.lds + (e / 144) * AT_BUF + AT_KB + 256 * 144 + (e % 144) * 16) = (v4u){0u, 0u, 0u, 0u};
    const int NU = 6144, nit = (NU - F.vcu + F.G - 1) / F.G;
    AtRegs RA, RB;
    if (nit > 0) { at_load(RA, at_decode(F.vcu), PROJ, F.tid, w8, g, i); at_store(RA, F.lds, F.tid); }
    bf16x8 qc0 = RA.q0, qc1 = RA.q1;
    if (nit > 1) at_load(RB, at_decode(F.vcu + F.G), PROJ, F.tid, w8, g, i);
    __syncthreads();
    for (int it = 0; it < nit; it += 2) {
        if (it + 2 < nit) at_load(RA, at_decode((it + 2) * F.G + F.vcu), PROJ, F.tid, w8, g, i);
        __builtin_amdgcn_sched_barrier(0);
        at_compute(at_decode(it * F.G + F.vcu), qc0, qc1, F.lds, OP, LSE, w8, g, i);
        if (it + 1 < nit) { at_store(RB, F.lds + AT_BUF, F.tid); qc0 = RB.q0; qc1 = RB.q1; }
        __syncthreads();
        if (it + 1 >= nit) break;
        if (it + 3 < nit) at_load(RB, at_decode((it + 3) * F.G + F.vcu), PROJ, F.tid, w8, g, i);
        __builtin_amdgcn_sched_barrier(0);
        at_compute(at_decode((it + 1) * F.G + F.vcu), qc0, qc1, F.lds + AT_BUF, OP, LSE, w8, g, i);
        if (it + 2 < nit) { at_store(RA, F.lds, F.tid); qc0 = RA.q0; qc1 = RA.q1; }
        __syncthreads();
    }
}

__device__ __forceinline__ void mlstm_out_unit(Frame& F, const unsigned char* wsb, const float* g_mh, int unit) {
    const int co = unit & 31, h = (unit >> 5) & 3, b = unit >> 7;
    const int lane = F.lane, g = lane >> 4, i = lane & 15, dir = F.wave >> 2, w4 = F.wave & 3;
    const int c = dir ? 31 - co : co, chain = (b * 4 + h) * 2 + dir;
    LAS unsigned char* VI = F.lds + dir * 18432;
    LAS float* BC = (LAS float*)(F.lds + 36864) + dir * 128; LAS float* LIc = BC + 64;
    LAS float* HB = (LAS float*)(F.lds + 40960);
    const float* GATES = (const float*)(wsb + WS_GATES); const bf16* PROJ = (const bf16*)(wsb + WS_R);
    const bf16* CST = (const bf16*)(wsb + WS_CST); const float* NST = (const float*)(wsb + WS_NST); const float* MST = (const float*)(wsb + WS_MST);
    bf16* XA = (bf16*)(wsb + WS_XA);
    const size_t rb = (size_t)b * 2048 + 64 * co;
#define TROW(s_) (dir ? 63 - (s_) : (s_))
    const int j = 16 * w4 + i, t256 = F.tid & 255;
    const float* gp = GATES + (rb + TROW(lane)) * 16; const float li = gp[(dir ? 8 : 0) + h]; float bc = gp[(dir ? 12 : 4) + h];
    v4u vr[4];
#pragma unroll
    for (int e = 0; e < 4; ++e) { const int idx = t256 + 256 * e, s = idx >> 4, ch = idx & 15; vr[e] = *(const v4u*)(PROJ + (rb + TROW(s)) * PW + 512 + h * 128 + ch * 8); }
    const bf16* qrow = PROJ + (rb + TROW(j)) * PW + h * 64; const bf16x8 qf0 = *(const bf16x8*)(qrow + 8 * g), qf1 = *(const bf16x8*)(qrow + 32 + 8 * g);
    bf16x8 cf[8][2];
#pragma unroll
    for (int vt = 0; vt < 8; ++vt) { const bf16* crow = CST + ((size_t)(chain * 32 + c) * 128 + 16 * vt + i) * 64; cf[vt][0] = *(const bf16x8*)(crow + 8 * g); cf[vt][1] = *(const bf16x8*)(crow + 32 + 8 * g); }
    bf16x8 kf[4][2];
#pragma unroll
    for (int tt = 0; tt < 4; ++tt) { const bf16* krow = PROJ + (rb + TROW(16 * tt + i)) * PW + 256 + h * 64; kf[tt][0] = *(const bf16x8*)(krow + 8 * g); kf[tt][1] = *(const bf16x8*)(krow + 32 + 8 * g); }
    const float* np = NST + (size_t)(chain * 32 + c) * 64 + 8 * g; const f32x4 n0 = *(const f32x4*)(np), n1 = *(const f32x4*)(np + 4), n2 = *(const f32x4*)(np + 32), n3 = *(const f32x4*)(np + 36);
    const float mst = MST[chain * 32 + c];
#pragma unroll
    for (int o = 1; o < 64; o <<= 1) { const float tt = __shfl_up(bc, o); if (lane >= o) bc += tt; }
    if (w4 == 0) { BC[lane] = bc; LIc[lane] = li; }
#pragma unroll
    for (int e = 0; e < 4; ++e) { const int idx = t256 + 256 * e, s = idx >> 4, ch = idx & 15; *(LAS v4u*)(VI + s * 288 + ch * 16) = vr[e]; }
    f32x4 acc[8];
#pragma unroll
    for (int vt = 0; vt < 8; ++vt) { f32x4 a = __builtin_amdgcn_mfma_f32_16x16x32_bf16(cf[vt][0], qf0, (f32x4){0.f, 0.f, 0.f, 0.f}, 0, 0, 0); acc[vt] = __builtin_amdgcn_mfma_f32_16x16x32_bf16(cf[vt][1], qf1, a, 0, 0, 0); }
    f32x4 st[4];
#pragma unroll
    for (int tt = 0; tt < 4; ++tt) { f32x4 a = __builtin_amdgcn_mfma_f32_16x16x32_bf16(kf[tt][0], qf0, (f32x4){0.f, 0.f, 0.f, 0.f}, 0, 0, 0); st[tt] = __builtin_amdgcn_mfma_f32_16x16x32_bf16(kf[tt][1], qf1, a, 0, 0, 0); }
    float nq;
    { const v4u q0 = __builtin_bit_cast(v4u, qf0), q1 = __builtin_bit_cast(v4u, qf1);
      nq = (n0[0] * bf_lo(q0.x) + n0[1] * bf_hi(q0.x)) + (n0[2] * bf_lo(q0.y) + n0[3] * bf_hi(q0.y)) + (n1[0] * bf_lo(q0.z) + n1[1] * bf_hi(q0.z)) + (n1[2] * bf_lo(q0.w) + n1[3] * bf_hi(q0.w))
         + (n2[0] * bf_lo(q1.x) + n2[1] * bf_hi(q1.x)) + (n2[2] * bf_lo(q1.y) + n2[3] * bf_hi(q1.y)) + (n3[0] * bf_lo(q1.z) + n3[1] * bf_hi(q1.z)) + (n3[2] * bf_lo(q1.w) + n3[3] * bf_hi(q1.w)); }
    nq += __shfl_xor(nq, 16); nq += __shfl_xor(nq, 32);
    u32x2 mo[8];
    if (dir == 0) {
#pragma unroll
        for (int vt = 0; vt < 8; ++vt) mo[vt] = *(const u32x2*)(PROJ + (rb + j) * PW + 1024 + h * 128 + 16 * vt + 4 * g); }
    __syncthreads();
    const float bj = BC[j], a_int = bj + mst;
    float mloc = -1e30f;
#pragma unroll
    for (int tt = 0; tt < 4; ++tt)
#pragma unroll
        for (int ii = 0; ii < 4; ++ii) { const int s = 16 * tt + 4 * g + ii; const float d = (s <= j) ? (bj - BC[s] + LIc[s]) : -1e30f; mloc = fmaxf(mloc, d); }
    mloc = fmaxf(mloc, __shfl_xor(mloc, 16)); mloc = fmaxf(mloc, __shfl_xor(mloc, 32));
    const float m_t = fmaxf(a_int, mloc), w_int = __expf(a_int - m_t); float psum = 0.f;
#pragma unroll
    for (int tt = 0; tt < 4; ++tt)
#pragma unroll
        for (int ii = 0; ii < 4; ++ii) { const int s = 16 * tt + 4 * g + ii; const float dd = (s <= j) ? (bj - BC[s] + LIc[s] - m_t) : -1e30f; const float pv = __expf(dd) * st[tt][ii]; st[tt][ii] = pv; psum += pv; }
    psum += __shfl_xor(psum, 16); psum += __shfl_xor(psum, 32);
#pragma unroll
    for (int vt = 0; vt < 8; ++vt) acc[vt] = acc[vt] * w_int;
#pragma unroll
    for (int kp = 0; kp < 2; ++kp) { const bf16x8 pf = pack_p(st[2 * kp], st[2 * kp + 1]);
        const LAS unsigned char* va = VI + (32 * kp + 4 * g + (i >> 2)) * 288 + 8 * (i & 3);
#pragma unroll
        for (int vt = 0; vt < 8; ++vt) { const s16x4 lo = vtr(va + 32 * vt), hi = vtr(va + 16 * 288 + 32 * vt); acc[vt] = __builtin_amdgcn_mfma_f32_16x16x32_bf16(MK8(lo, hi), pf, acc[vt], 0, 0, 0); } }
    const float den = w_int * nq + psum, inv = 1.f / fmaxf(fabsf(den), __expf(-m_t));
    if (dir == 1) {
#pragma unroll
        for (int vt = 0; vt < 8; ++vt) *(LAS f32x4*)(HB + (63 - j) * 132 + 16 * vt + 4 * g) = acc[vt] * inv; }
    __syncthreads();
    if (dir == 0) { float ss = 0.f;
#pragma unroll
        for (int vt = 0; vt < 8; ++vt) { const f32x4 hv = acc[vt] * inv + *(const LAS f32x4*)(HB + j * 132 + 16 * vt + 4 * g); acc[vt] = hv; ss += (hv[0] * hv[0] + hv[1] * hv[1]) + (hv[2] * hv[2] + hv[3] * hv[3]); }
        ss += __shfl_xor(ss, 16); ss += __shfl_xor(ss, 32);
        const float rn = rsqrtf(ss * (1.0f / 128.0f) + EPS);
#pragma unroll
        for (int vt = 0; vt < 8; ++vt) { const int col = h * 128 + 16 * vt + 4 * g; const f32x4 gm = *(const f32x4*)(g_mh + col);
            const float o0 = acc[vt][0] * rn * gm[0] / (1.f + __expf(-bf_lo(mo[vt].x))), o1 = acc[vt][1] * rn * gm[1] / (1.f + __expf(-bf_hi(mo[vt].x))), o2 = acc[vt][2] * rn * gm[2] / (1.f + __expf(-bf_lo(mo[vt].y))), o3 = acc[vt][3] * rn * gm[3] / (1.f + __expf(-bf_hi(mo[vt].y)));
            u32x2 w; w.x = pk2(o0, o1); w.y = pk2(o2, o3); *(u32x2*)(XA + (rb + j) * D + col) = w; } }
    __syncthreads();
#undef TROW
}
__device__ __forceinline__ void attn_merge(Frame& F, const unsigned char* wsb) {
    const bf16* OP = (const bf16*)(wsb + WS_OP); const float* LSE = (const float*)(wsb + WS_LSE); bf16* XA = (bf16*)(wsb + WS_XA);
    const int stride = F.G * 512;
    for (int idx0 = (F.vcu * 512 + F.tid); idx0 < T * 64; idx0 += 4 * stride) {
        float l0[4], l1[4], l2[4]; v4u a[4], bq[4], cq[4];
#pragma unroll
        for (int q = 0; q < 4; ++q) { const int idx = idx0 + q * stride, row = idx >> 6, hd = (idx >> 3) & 7, ch = idx & 7; const size_t off = (size_t)row * 512 + hd * 64 + ch * 8;
            l0[q] = LSE[(size_t)row * 8 + hd]; l1[q] = LSE[((size_t)T + row) * 8 + hd]; l2[q] = LSE[((size_t)2 * T + row) * 8 + hd];
            a[q] = *(const v4u*)(OP + off); bq[q] = *(const v4u*)(OP + (size_t)T * 512 + off); cq[q] = *(const v4u*)(OP + (size_t)2 * T * 512 + off); }
#pragma unroll
        for (int q = 0; q < 4; ++q) { const int idx = idx0 + q * stride, row = idx >> 6, hd = (idx >> 3) & 7, ch = idx & 7;
            const float mx = fmaxf(l0[q], fmaxf(l1[q], l2[q])); float w0 = __expf(l0[q] - mx), w1 = __expf(l1[q] - mx), w2 = __expf(l2[q] - mx); const float inv = 1.f / (w0 + w1 + w2); w0 *= inv; w1 *= inv; w2 *= inv;
            v4u o;
            o.x = pk2(w0 * bf_lo(a[q].x) + w1 * bf_lo(bq[q].x) + w2 * bf_lo(cq[q].x), w0 * bf_hi(a[q].x) + w1 * bf_hi(bq[q].x) + w2 * bf_hi(cq[q].x));
            o.y = pk2(w0 * bf_lo(a[q].y) + w1 * bf_lo(bq[q].y) + w2 * bf_lo(cq[q].y), w0 * bf_hi(a[q].y) + w1 * bf_hi(bq[q].y) + w2 * bf_hi(cq[q].y));
            o.z = pk2(w0 * bf_lo(a[q].z) + w1 * bf_lo(bq[q].z) + w2 * bf_lo(cq[q].z), w0 * bf_hi(a[q].z) + w1 * bf_hi(bq[q].z) + w2 * bf_hi(cq[q].z));
            o.w = pk2(w0 * bf_lo(a[q].w) + w1 * bf_lo(bq[q].w) + w2 * bf_lo(cq[q].w), w0 * bf_hi(a[q].w) + w1 * bf_hi(bq[q].w) + w2 * bf_hi(cq[q].w));
            *(v4u*)(XA + (size_t)row * D + 512 + hd * 64 + ch * 8) = o; } }
}
__device__ __forceinline__ void normmod_row(int lane, const float* xrow, const float* g, const float* sc, const float* sh, bf16* orow) {
    const GAS f32x4* xr = (const GAS f32x4*)xrow + lane;
    f32x4 v[4]; float s2 = 0.f;
#pragma unroll
    for (int j = 0; j < 4; ++j) { v[j] = xr[64 * j]; s2 += (v[j].x * v[j].x + v[j].y * v[j].y) + (v[j].z * v[j].z + v[j].w * v[j].w); }
    const float rstd = rsqrtf(wave_sum(s2) * (1.f / D) + EPS);
    GAS unsigned long long* o8 = (GAS unsigned long long*)orow + lane;
#pragma unroll
    for (int j = 0; j < 4; ++j) { const f32x4 gg = *((const f32x4*)g + lane + 64 * j), cc = *((const f32x4*)sc + lane + 64 * j), hh = *((const f32x4*)sh + lane + 64 * j);
        const f32x4 o = v[j] * rstd * gg * (cc + 1.0f) + hh;
        o8[64 * j] = (unsigned long long)pk2(o.x, o.y) | ((unsigned long long)pk2(o.z, o.w) << 32); }
}
__device__ __forceinline__ void normmod_row2(int lane, const float* xrow, const float* g, const float* sc, const float* sh, bf16* orow) {
    const GAS f32x4* xr = (const GAS f32x4*)xrow + lane;
    f32x4 v[2][4]; float s2[2] = {0.f, 0.f};
#pragma unroll
    for (int r = 0; r < 2; ++r)
#pragma unroll
        for (int j = 0; j < 4; ++j) v[r][j] = xr[256 * r + 64 * j];
    f32x4 gg[4], cc[4], hh[4];
#pragma unroll
    for (int j = 0; j < 4; ++j) { gg[j] = *((const f32x4*)g + lane + 64 * j); cc[j] = *((const f32x4*)sc + lane + 64 * j); hh[j] = *((const f32x4*)sh + lane + 64 * j); }
#pragma unroll
    for (int r = 0; r < 2; ++r)
#pragma unroll
        for (int j = 0; j < 4; ++j) s2[r] += (v[r][j].x * v[r][j].x + v[r][j].y * v[r][j].y) + (v[r][j].z * v[r][j].z + v[r][j].w * v[r][j].w);
#pragma unroll
    for (int r = 0; r < 2; ++r) { const float rstd = rsqrtf(wave_sum(s2[r]) * (1.f / D) + EPS);
        GAS unsigned long long* o8 = (GAS unsigned long long*)(orow + (size_t)r * D) + lane;
#pragma unroll
        for (int j = 0; j < 4; ++j) { const f32x4 o = v[r][j] * rstd * gg[j] * (cc[j] + 1.0f) + hh[j]; o8[64 * j] = (unsigned long long)pk2(o.x, o.y) | ((unsigned long long)pk2(o.z, o.w) << 32); } }
}
__device__ __forceinline__ void finalnorm_row(int lane, const float* xrow, float* orow, const float* g) {
    const GAS f32x4* xr = (const GAS f32x4*)xrow + lane; GAS f32x4* xo = (GAS f32x4*)orow + lane;
    f32x4 v[4]; float s2 = 0.f;
#pragma unroll
    for (int j = 0; j < 4; ++j) { v[j] = xr[64 * j]; s2 += (v[j].x * v[j].x + v[j].y * v[j].y) + (v[j].z * v[j].z + v[j].w * v[j].w); }
    const float rstd = rsqrtf(wave_sum(s2) * (1.f / D) + EPS);
#pragma unroll
    for (int j = 0; j < 4; ++j) xo[64 * j] = v[j] * rstd * *((const f32x4*)g + lane + 64 * j);
}
__device__ __forceinline__ float logsigmoid_f(float x) { return fminf(x, 0.f) - log1pf(expf(-fabsf(x))); }

struct Args { const float* in[18]; float* out; unsigned char* ws; int ph_lo, ph_hi, li, pad; };
constexpr int N_PHASES = 11;
#ifndef PROBE_DUP
#define PROBE_DUP 0
#endif
#ifndef PROBE_TIME
#define PROBE_TIME -1
#endif
#define PROBE_AMP 4
__global__ void __launch_bounds__(NWAVES * 64, 2) mk_fwd(Args args) {
    extern __shared__ __attribute__((aligned(16))) unsigned char lds[];
    Frame F;
    F.lds = (LAS unsigned char*)lds; F.MISC = (volatile LAS unsigned*)(F.lds + MISC_OFF);
    F.tid = threadIdx.x; F.lane = F.tid & 63; F.wave = __builtin_amdgcn_readfirstlane(F.tid >> 6);
    F.G = gridDim.x; { const int bx = blockIdx.x; F.vcu = (F.G % 8 == 0) ? (bx % 8) * (F.G / 8) + bx / 8 : bx; }
    F.ctl = (gu32*)(args.ws + WS_CTL);
#define WSP(type, off) ((type*)(args.ws + (off)))
#define MOD WSP(float, WS_MOD)
#define GM2 WSP(float, WS_GM2)
#define GM3 WSP(float, WS_GM3)
#define ROPEC WSP(float, WS_ROPEC)
#define ROPES WSP(float, WS_ROPES)
#define SHW2 WSP(float, WS_SHW2)
#define SHW3 WSP(float, WS_SHW3)
#define SSQ2 WSP(float, WS_SSQ2)
#define SSQ3 WSP(float, WS_SSQ3)
#define SSQ4 WSP(float, WS_SSQ4)
#define GATES WSP(float, WS_GATES)
#define WGU1 WSP(bf16, WS_WGU1)
#define WD1 WSP(bf16, WS_WD1)
#define WIN WSP(bf16, WS_WIN)
#define WOUT WSP(bf16, WS_WOUT)
#define WGU2 WSP(bf16, WS_WGU2)
#define WD2 WSP(bf16, WS_WD2)
#define XA WSP(bf16, WS_XA)
#define ACT WSP(bf16, WS_R)
#define PROJ WSP(bf16, WS_R)
#define XG3 WSP(bf16, WS_XG3)
#define x_in args.in[0]
#define c_in args.in[1]
#define w_ada args.in[2]
#define b_ada args.in[3]
#define g_ffn1 args.in[4]
#define w_gu1 args.in[5]
#define w_down1 args.in[6]
#define g_mix args.in[7]
#define w_in args.in[8]
#define gate_bias args.in[9]
#define g_q args.in[10]
#define g_k args.in[11]
#define g_mh args.in[12]
#define w_out args.in[13]
#define g_ffn2 args.in[14]
#define w_gu2 args.in[15]
#define w_down2 args.in[16]
#define g_final args.in[17]
#define out args.out
    for (int u = F.tid; u < (LDS_BYTES - LDSCTL_OFF) / 4; u += NWAVES * 64) ((LAS unsigned*)(F.lds + LDSCTL_OFF))[u] = 0u;
    __syncthreads();
    XcdBarrier bar = xcd_barrier_post((unsigned*)(F.ctl + CW_BAR) + args.li * XCD_BAR_WORDS, F.MISC + 8);
    const int lo = args.ph_lo, hi = args.ph_hi, bx = blockIdx.x;
    const int gw = F.vcu * NWAVES + F.wave, NGW = F.G * NWAVES;
#define IN(k) (lo <= (k) && (k) < hi)
#define SEAM(k) do { if ((k) + 1 < hi) xcd_barrier(bar); } while (0)
#define NREP(k) (1 + ((PROBE_DUP >> (k)) & 1))
    unsigned long long pt0 = 0, ptT = 0;
#define TB(id) do { if (PROBE_TIME == (id)) pt0 = __builtin_amdgcn_s_memrealtime(); } while (0)
#define TE(id) do { if (PROBE_TIME == (id)) ptT += __builtin_amdgcn_s_memrealtime() - pt0; } while (0)
#define DRY(k) (NREP(k) == 2 && rep == 0)

    if (IN(0)) { TB(0);
      for (int rep = 0; rep < NREP(0); ++rep) { asm volatile("" ::: "memory");
        if (bx < 144) { float r[2]; colblock16(F, w_ada, NMOD * D, 64 * bx, 64, c_in, D, true, r[0], r[1]);
#pragma unroll
            for (int i = 0; i < 2; ++i) { const int e = F.tid + 512 * i, b = e >> 6, col = 64 * bx + (e & 63); MOD[(size_t)b * (NMOD * D) + col] = r[i] + b_ada[col]; } }
        { const int gid = bx * 512 + F.tid; if (gid < 16384) { const int pos = gid >> 3, i = gid & 7; const float inv = powf(500000.f, -2.f * (float)i / 16.f), ang = (float)pos * inv; ROPEC[gid] = cosf(ang); ROPES[gid] = sinf(ang); } }
        constexpr int I_GU = 32 * 88, I_DN = 88 * 16, I_IN = 32 * 49, I_OUT = 32 * 16, NITEMS = 2 * I_GU + 2 * I_DN + I_IN + I_OUT;
        for (int it = gw; it < NITEMS; it += NGW) {
            int r = it;
            if (r < I_GU) { p0_transpose_item<1>(w_gu1, D, 2 * DFF, WGU1, r, F.lane); continue; } r -= I_GU;
            if (r < I_GU) { p0_transpose_item<1>(w_gu2, D, 2 * DFF, WGU2, r, F.lane); continue; } r -= I_GU;
            if (r < I_DN) { p0_transpose_item<0>(w_down1, DFF, D, WD1, r, F.lane); continue; } r -= I_DN;
            if (r < I_DN) { p0_transpose_item<0>(w_down2, DFF, D, WD2, r, F.lane); continue; } r -= I_DN;
            if (r < I_IN) { p0_transpose_item<2>(w_in, D, INC, WIN, r, F.lane); continue; } r -= I_IN;
            p0_transpose_item<0>(w_out, D, D, WOUT, r, F.lane);
        }
        if (rep + 1 < NREP(0)) xcd_barrier(bar);
      }
        SEAM(0); TE(0);
    }
    if (IN(1)) { TB(1);
      for (int rep = 0; rep < NREP(1); ++rep) { asm volatile("" ::: "memory");
        if (bx < 49) { float r[2]; const int n0 = 64 * bx; colblock16(F, w_in, INC, n0, INC - n0 < 64 ? INC - n0 : 64, MOD + 3 * D, NMOD * D, false, r[0], r[1]);
#pragma unroll
            for (int i = 0; i < 2; ++i) { const int e = F.tid + 512 * i, b = e >> 6, n = n0 + (e & 63); if (n < INC) SHW2[(size_t)b * INC + map_in(n)] = r[i]; } }
        else if (bx < 49 + 88) { float r[2]; const int n0 = 64 * (bx - 49); colblock16(F, w_gu2, 2 * DFF, n0, 64, MOD + 6 * D, NMOD * D, false, r[0], r[1]);
#pragma unroll
            for (int i = 0; i < 2; ++i) { const int e = F.tid + 512 * i, b = e >> 6, n = n0 + (e & 63); SHW3[(size_t)b * (2 * DFF) + map_gu(n)] = r[i]; } }
        { const int gid = bx * 512 + F.tid; if (gid < 16384) { const int b = gid >> 10, k = gid & 1023; GM2[gid] = g_mix[k] * (1.f + MOD[(size_t)b * (NMOD * D) + 4 * D + k]); GM3[gid] = g_ffn2[k] * (1.f + MOD[(size_t)b * (NMOD * D) + 7 * D + k]); } }
        for (int m = 2 * gw; m < T; m += 2 * NGW) { const int b = m >> 11; normmod_row2(F.lane, x_in + (size_t)m * D, g_ffn1, MOD + (size_t)b * (NMOD * D) + 1 * D, MOD + (size_t)b * (NMOD * D) + 0 * D, XA + (size_t)m * D); }
        if (rep + 1 < NREP(1)) xcd_barrier(bar);
      }
        SEAM(1); TE(1);
    }
    if (IN(2)) { TB(2);
      for (int rep = 0; rep < NREP(2); ++rep) { asm volatile("" ::: "memory");
        pg8::Gemm g{XA, WGU1, T, 2 * DFF, D}; pg8::StaticOrder So; So.init(T, 2 * DFF, F.G, bx);
        pg8::EpiSwiGLU<false> E{ACT, nullptr, nullptr};
        pg8::gemm_phase<pg8::EpiSwiGLU<false>, pg8::StaticOrder, true, true>(F.lds + RING_OFF, g, So, E);
        if (rep + 1 < NREP(2)) xcd_barrier(bar);
      }
        SEAM(2); TE(2);
    }
    if (IN(3)) { TB(3);
      for (int rep = 0; rep < NREP(3); ++rep) { asm volatile("" ::: "memory");
        pg8::Gemm g{ACT, WD1, T, D, DFF}; pg8::StaticOrder So; So.init(T, D, F.G, bx);
        pg8::EpiRes<true, true> E{x_in, out, MOD + 2 * D, XA, GM2, SSQ2};
        pg8::gemm_phase<pg8::EpiRes<true, true>, pg8::StaticOrder, true, true>(F.lds + RING_OFF, g, So, E);
        if (rep + 1 < NREP(3)) xcd_barrier(bar);
      }
        SEAM(3); TE(3);
    }
    if (IN(4)) { TB(4);
      for (int rep = 0; rep < NREP(4); ++rep) { asm volatile("" ::: "memory");
        { const int fr = F.lane & 15, fq = F.lane >> 4;
          for (int rt = gw; rt < T / 16; rt += NGW) {
            const int row = rt * 16 + fr; f32x4 acc = {0.f, 0.f, 0.f, 0.f};
            const bf16* ap = XA + (size_t)row * D + fq * 8; const bf16* bp = WIN + (size_t)(3072 + fr) * D + fq * 8;
#pragma unroll 8
            for (int ks = 0; ks < 32; ++ks) { const bf16x8 a = *(const bf16x8*)(ap + ks * 32), bb = *(const bf16x8*)(bp + ks * 32); acc = __builtin_amdgcn_mfma_f32_16x16x32_bf16(bb, a, acc, 0, 0, 0); }
            const float rs = pg8::row_rstd(SSQ2, row, fq); const int b = row >> 11; f32x4 o;
#pragma unroll
            for (int i = 0; i < 4; ++i) { const int j = 4 * fq + i; float v = acc[i] * rs + SHW2[(size_t)b * INC + 3072 + j] + gate_bias[j]; if (fq & 1) v = logsigmoid_f(v); o[i] = v; }
            *(f32x4*)(GATES + (size_t)row * 16 + 4 * fq) = o; } }
        pg8::Gemm g{XA, WIN, T, PW, D}; pg8::StaticOrder So; So.init(T, PW, F.G, bx);
        pg8::EpiProj E{PROJ, SSQ2, SHW2, g_q, g_k, ROPEC, ROPES};
        pg8::gemm_phase<pg8::EpiProj, pg8::StaticOrder, true, true>(F.lds + RING_OFF, g, So, E);
        if (rep + 1 < NREP(4)) xcd_barrier(bar);
      }
        SEAM(4); TE(4);
    }
    if (IN(5)) { TB(5);
        TB(50); for (int rep = 0; rep < NREP(5); ++rep) { asm volatile("" ::: "memory"); for (int task = bx; task < 256; task += F.G) mlstm_scan_task(F, args.ws, task); if (rep + 1 < NREP(5)) xcd_barrier(bar); }
        TE(50); TB(51); for (int rep = 0; rep < NREP(11); ++rep) { asm volatile("" ::: "memory"); attn_units(F, args.ws); if (rep + 1 < NREP(11)) xcd_barrier(bar); }
        TE(51); SEAM(5); TE(5);
    }
    if (IN(6)) { TB(6);
        TB(60); for (int rep = 0; rep < NREP(6); ++rep) { asm volatile("" ::: "memory"); for (int un = F.vcu; un < 2048; un += F.G) mlstm_out_unit(F, args.ws, g_mh, un); if (rep + 1 < NREP(6)) xcd_barrier(bar); }
        TE(60); TB(61); for (int rep = 0; rep < NREP(12); ++rep) { asm volatile("" ::: "memory"); attn_merge(F, args.ws); if (rep + 1 < NREP(12)) xcd_barrier(bar); }
        TE(61); SEAM(6); TE(6);
    }
    if (IN(7)) { TB(7);
      for (int rep = 0; rep < NREP(7); ++rep) { asm volatile("" ::: "memory");
        pg8::Gemm g{XA, WOUT, T, D, D}; pg8::StaticOrder So; So.init(T, D, F.G, bx);
        pg8::EpiRes<true, false> E{out, DRY(7) ? WSP(float, WS_R) : out, MOD + 5 * D, XG3, GM3, SSQ3};
        pg8::gemm_phase<pg8::EpiRes<true, false>, pg8::StaticOrder, true, true>(F.lds + RING_OFF, g, So, E);
        if (rep + 1 < NREP(7)) xcd_barrier(bar);
      }
        SEAM(7); TE(7);
    }
    if (IN(8)) { TB(8);
      for (int rep = 0; rep < NREP(8); ++rep) { asm volatile("" ::: "memory");
        pg8::Gemm g{XG3, WGU2, T, 2 * DFF, D}; pg8::StaticOrder So; So.init(T, 2 * DFF, F.G, bx);
        pg8::EpiSwiGLU<true> E{ACT, SSQ3, SHW3};
        pg8::gemm_phase<pg8::EpiSwiGLU<true>, pg8::StaticOrder, true, true>(F.lds + RING_OFF, g, So, E);
        if (rep + 1 < NREP(8)) xcd_barrier(bar);
      }
        SEAM(8); TE(8);
    }
    if (IN(9)) { TB(9);
      for (int rep = 0; rep < NREP(9); ++rep) { asm volatile("" ::: "memory");
        pg8::Gemm g{ACT, WD2, T, D, DFF}; pg8::StaticOrder So; So.init(T, D, F.G, bx);
        pg8::EpiRes<false, true> E{out, DRY(9) ? WSP(float, WS_MIX) : out, MOD + 8 * D, nullptr, nullptr, SSQ4};
        pg8::gemm_phase<pg8::EpiRes<false, true>, pg8::StaticOrder, true, true>(F.lds + RING_OFF, g, So, E);
        if (rep + 1 < NREP(9)) xcd_barrier(bar);
      }
        SEAM(9); TE(9);
    }
    if (IN(10)) { TB(10); for (int rep = 0; rep < NREP(10); ++rep) { asm volatile("" ::: "memory"); float* dst = DRY(10) ? WSP(float, WS_MIX) : out; for (int m = gw; m < T; m += NGW) finalnorm_row(F.lane, out + (size_t)m * D, dst + (size_t)m * D, g_final); if (rep + 1 < NREP(10)) xcd_barrier(bar); } }
    if (PROBE_TIME >= 0) { if (PROBE_TIME == 10) TE(10);
        if (blockIdx.x == 0) { const unsigned long long tend = __builtin_amdgcn_s_memrealtime() + PROBE_AMP * ptT; while (__builtin_amdgcn_s_memrealtime() < tend) __builtin_amdgcn_s_sleep(8); } }
#undef IN
#undef SEAM
#undef TB
#undef TE
#undef NREP
#undef DRY
}
#undef WSP
#undef MOD
#undef GM2
#undef GM3
#undef ROPEC
#undef ROPES
#undef SHW2
#undef SHW3
#undef SSQ2
#undef SSQ3
#undef SSQ4
#undef GATES
#undef WGU1
#undef WD1
#undef WIN
#undef WOUT
#undef WGU2
#undef WD2
#undef XA
#undef ACT
#undef PROJ
#undef XG3
#undef x_in
#undef c_in
#undef w_ada
#undef b_ada
#undef g_ffn1
#undef w_gu1
#undef w_down1
#undef g_mix
#undef w_in
#undef gate_bias
#undef g_q
#undef g_k
#undef g_mh
#undef w_out
#undef g_ffn2
#undef w_gu2
#undef w_down2
#undef g_final
#undef out
namespace v1 {
__device__ __forceinline__ float bf2f(unsigned short h) { return __uint_as_float(((unsigned)h) << 16); }
__device__ __forceinline__ unsigned short f2bf_(float f) { unsigned u = __float_as_uint(f); return (unsigned short)((u + 0x7fffu + ((u >> 16) & 1u)) >> 16); }
__device__ __forceinline__ float sigmoidf_(float x) { return 1.f / (1.f + expf(-x)); }
__global__ void k_gates(const float* gates, float* LI, float* BC, float* MT) {
    int chain = blockIdx.x * blockDim.x + threadIdx.x; if (chain >= NB * MH * 2) return;
    int dir = chain % 2, h = (chain / 2) % MH, b = chain / (2 * MH);
    float bc = 0.f, pm = -1e30f;
    for (int j = 0; j < S; ++j) { int t = dir ? (S - 1 - j) : j; const float* g = gates + (size_t)(b * S + t) * 16;
        float li = g[(dir ? 8 : 0) + h], lf = g[(dir ? 12 : 4) + h];
        bc += lf; pm = fmaxf(pm, li - bc);
        LI[(size_t)chain * S + j] = li; BC[(size_t)chain * S + j] = bc; MT[(size_t)chain * S + j] = bc + pm; }
}
__global__ void k_mlstm(const bf16* proj, const float* LI, const float* BC, const float* MT, float* H  ) {
    __shared__ float qs[16][65], ks[64][65], vs[64][129], P[16][65];
    int chain = blockIdx.y, dir = chain % 2, h = (chain / 2) % MH, b = chain / (2 * MH);
    int j0 = blockIdx.x * 16; int tid = threadIdx.x;
    const float* li = LI + (size_t)chain * S; const float* bc = BC + (size_t)chain * S; const float* mt = MT + (size_t)chain * S;
    for (int e = tid; e < 16 * 64; e += 256) { int r = e / 64, d = e % 64; int j = j0 + r; int t = dir ? S - 1 - j : j; qs[r][d] = bf2f(proj[(size_t)(b * S + t) * PW + h * 64 + d]); }
    int tq = tid / 16, vg = tid % 16;
    float num[8] = {}; float den = 0.f;
    for (int s0 = 0; s0 <= j0 + 15; s0 += 64) {
        __syncthreads();
        for (int e = tid; e < 64 * 64; e += 256) { int r = e / 64, d = e % 64; int j = s0 + r; float v = 0.f; if (j < S) { int t = dir ? S - 1 - j : j; v = bf2f(proj[(size_t)(b * S + t) * PW + 256 + h * 64 + d]); } ks[r][d] = v; }
        for (int e = tid; e < 64 * 128; e += 256) { int r = e / 128, d = e % 128; int j = s0 + r; float v = 0.f; if (j < S) { int t = dir ? S - 1 - j : j; v = bf2f(proj[(size_t)(b * S + t) * PW + 512 + h * 128 + d]); } vs[r][d] = v; }
        __syncthreads();
        for (int i = 0; i < 4; ++i) { int sl = vg * 4 + i; int js = s0 + sl; int jq = j0 + tq; float p = 0.f;
            if (js <= jq && js < S) { float dot = 0.f; for (int d = 0; d < 64; ++d) dot += qs[tq][d] * ks[sl][d];
                p = expf(bc[jq] - bc[js] + li[js] - mt[jq]) * dot; }
            P[tq][sl] = p; }
        __syncthreads();
        for (int sl = 0; sl < 64; ++sl) { float p = P[tq][sl]; den += p; for (int i = 0; i < 8; ++i) num[i] += p * vs[sl][vg * 8 + i]; }
    }
    int jq = j0 + tq; int t = dir ? S - 1 - jq : jq;
    float dn = fmaxf(fabsf(den), expf(-mt[jq]));
    for (int i = 0; i < 8; ++i) H[((size_t)dir * T + (size_t)(b * S + t)) * 512 + h * 128 + vg * 8 + i] = num[i] / dn;
}
__global__ void k_mlstm_fin(const float* H, const bf16* proj, const float* gmh, bf16* hmix) {
    int w = (blockIdx.x * blockDim.x + threadIdx.x) / 64, lane = threadIdx.x & 63; if (w >= T * MH) return;
    int h = w % MH, t = w / MH;
    float a0 = H[(size_t)t * 512 + h * 128 + lane] + H[((size_t)T + t) * 512 + h * 128 + lane];
    float a1 = H[(size_t)t * 512 + h * 128 + 64 + lane] + H[((size_t)T + t) * 512 + h * 128 + 64 + lane];
    float ss = a0 * a0 + a1 * a1; for (int o = 32; o > 0; o >>= 1) ss += __shfl_xor(ss, o);
    float r = rsqrtf(ss / 128.f + EPS);
    float o0 = bf2f(proj[(size_t)t * PW + 1024 + h * 128 + lane]), o1 = bf2f(proj[(size_t)t * PW + 1024 + h * 128 + 64 + lane]);
    hmix[(size_t)t * D + h * 128 + lane] = f2bf_(a0 * r * gmh[h * 128 + lane] * sigmoidf_(o0));
    hmix[(size_t)t * D + h * 128 + 64 + lane] = f2bf_(a1 * r * gmh[h * 128 + 64 + lane] * sigmoidf_(o1));
}
__global__ void k_attn(const bf16* proj, bf16* hmix) {
    int w = (blockIdx.x * blockDim.x + threadIdx.x) / 64, lane = threadIdx.x & 63; if (w >= T * AH) return;
    int hd = w % AH, tg = w / AH, b = tg / S, t = tg % S;
    float q = bf2f(proj[(size_t)tg * PW + 1536 + hd * AD + lane]);
    float m = -1e30f, l = 0.f, o = 0.f;
    for (int p = 0; p < 3; ++p) { int dil = p == 0 ? 1 : (p == 1 ? 4 : 16);
        for (int j = -64; j <= 64; ++j) { int tk = t + j * dil; if (tk < 0 || tk >= S) continue;
            size_t row = (size_t)(b * S + tk) * PW;
            float s = q * bf2f(proj[row + 2048 + hd * AD + lane]);
            for (int of = 32; of > 0; of >>= 1) s += __shfl_xor(s, of);
            float mn = fmaxf(m, s), f = expf(m - mn), pe = expf(s - mn);
            l = l * f + pe; o = o * f + pe * bf2f(proj[row + 2560 + hd * AD + lane]); m = mn; } }
    hmix[(size_t)tg * D + 512 + hd * AD + lane] = f2bf_(o / l);
}
}

static void launch_mk(Args a, int lo, int hi, int li, int grid, hipStream_t stream) {
    a.ph_lo = lo; a.ph_hi = hi; a.li = li;
    hipLaunchKernelGGL(mk_fwd, dim3(grid), dim3(NWAVES * 64), LDS_BYTES, stream, a);
    const hipError_t le = hipPeekAtLastError();
    if (le != hipSuccess) fprintf(stderr, "kernel_launch: mk_fwd[%d,%d) failed: %s\n", lo, hi, hipGetErrorName(le));
}
extern "C" void kernel_launch(void* const* d_in, const int* in_sizes, int n_in, void* d_out, int out_size, void* d_ws, size_t ws_size, hipStream_t stream) {
    static int grid = 0;
    if (grid == 0) {
        if (n_in != 18 || in_sizes[0] != T * D || out_size != T * D || ws_size < WS_END) { fprintf(stderr, "kernel_launch: unexpected shapes / workspace (n_in %d, ws %zu < %zu); nothing launched\n", n_in, ws_size, (size_t)WS_END); grid = -1; return; }
        int dev = 0, cus = 0;
        if (hipGetDevice(&dev) != hipSuccess || hipDeviceGetAttribute(&cus, hipDeviceAttributeMultiprocessorCount, dev) != hipSuccess) { grid = -1; return; }
        if (hipFuncSetAttribute((const void*)mk_fwd, hipFuncAttributeMaxDynamicSharedMemorySize, LDS_BYTES) != hipSuccess) { fprintf(stderr, "kernel_launch: hipFuncSetAttribute failed\n"); grid = -1; return; }
        (void)hipGetLastError();
        grid = cus;
        if (grid != 256) fprintf(stderr, "kernel_launch: %d CUs (built for 256)\n", grid);
    }
    if (grid < 0) return;
    if (hipMemsetAsync((char*)d_ws + WS_CTL, 0, CTL_ZERO_BYTES, stream) != hipSuccess) return;
    Args a{};
    for (int i = 0; i < 18; ++i) a.in[i] = (const float*)d_in[i];
    a.out = (float*)d_out; a.ws = (unsigned char*)d_ws;
    unsigned char* ws = (unsigned char*)d_ws;
#ifndef MIXER_V1
#define MIXER_V1 0
#endif
#if MIXER_V1
    launch_mk(a, 0, 5, 0, grid, stream);
    {
        const bf16* PROJ = (const bf16*)(ws + WS_R); bf16* XA = (bf16*)(ws + WS_XA); const float* GATES = (const float*)(ws + WS_GATES);
        float* LI = (float*)(ws + WS_MIX); float* BC = LI + (size_t)128 * S; float* MT = BC + (size_t)128 * S; float* H = (float*)(ws + WS_MIX + 64 * MiB);
        v1::k_gates<<<2, 64, 0, stream>>>(GATES, LI, BC, MT);
        v1::k_mlstm<<<dim3(S / 16, NB * MH * 2), 256, 0, stream>>>(PROJ, LI, BC, MT, H);
        v1::k_mlstm_fin<<<(T * MH * 64 + 255) / 256, 256, 0, stream>>>(H, PROJ, (const float*)d_in[12], XA);
        v1::k_attn<<<(T * AH * 64 + 255) / 256, 256, 0, stream>>>(PROJ, XA);
    }
    launch_mk(a, 7, 11, 1, grid, stream);
#else
    launch_mk(a, 0, 11, 0, grid, stream);
#endif
}
```
